# Optimizing an MI355X kernel written in HIP

```python
import math
import jax, jax.numpy as jnp
from jax import lax
import numpy as np

D_MODEL = 1024
BATCH = 8
SEQ = 2048
DEPTH = 2

N_MIXERS = 2
EXPAND = 2
BRANCH_WIDTH = EXPAND * D_MODEL
HG_HEAD_DIM = 128
HG_HEADS = BRANCH_WIDTH // HG_HEAD_DIM
HG_CHUNK = 16
SW_HEAD_DIM = 64
SW_Q_HEADS = BRANCH_WIDTH // SW_HEAD_DIM
SW_KV_HEADS = SW_Q_HEADS // 8
SW_GROUP = SW_Q_HEADS // SW_KV_HEADS
SW_Q_WIDTH = SW_Q_HEADS * SW_HEAD_DIM
SW_KV_WIDTH = SW_KV_HEADS * SW_HEAD_DIM
SW_WINDOW = 128
SW_BLOCK = 128
SW_SCALE = SW_HEAD_DIM ** -0.5
N_A = (DEPTH + 1) // 2
N_B = DEPTH // 2
DEEPNORM_ALPHA = (2.0 * DEPTH) ** 0.25
DEEPNORM_BETA = (8.0 * DEPTH) ** -0.25
LN_EPS = 1e-5
RMS_EPS = 1e-6
ADA_INIT = 0.2

kernel_name = 'hybrid_hgrn2_swa_sink_adaln_deepnorm'


def layer_norm(x, g, b):
    xf = x.astype(jnp.float32)
    mu = jnp.mean(xf, axis=-1, keepdims=True)
    var = jnp.mean(jnp.square(xf - mu), axis=-1, keepdims=True)
    y = (xf - mu) * lax.rsqrt(var + LN_EPS) * g.astype(jnp.float32) + b.astype(jnp.float32)
    return y.astype(x.dtype)


def rms_norm(x):
    return x * lax.rsqrt(jnp.mean(jnp.square(x), axis=-1, keepdims=True) + RMS_EPS)


def alibi_slopes(n):
    return jnp.asarray(2.0 ** (-8.0 * np.arange(1, n + 1) / n), dtype=jnp.float32)


def chunked_gated_recurrence(q, k, v, log_f):
    B, T, H, K = q.shape
    V = v.shape[-1]
    C = HG_CHUNK
    N = T // C

    def to_chunks(a):
        return a.reshape(B, N, C, H, a.shape[-1]).transpose(1, 0, 3, 2, 4)

    qc, kc, vc, gc = to_chunks(q), to_chunks(k), to_chunks(v), to_chunks(log_f)
    bc = jnp.cumsum(gc, axis=-2)
    causal = jnp.tril(jnp.ones((C, C), dtype=bool))[:, :, None]

    def step(S, xs):
        q_, k_, v_, b_ = xs
        b_last = b_[..., -1, :]
        inter = jnp.einsum('bhtk,bhkv->bhtv', q_ * jnp.exp(b_), S)
        rel = jnp.where(causal, b_[..., :, None, :] - b_[..., None, :, :], -jnp.inf)
        decay = jnp.exp(rel)
        scores = jnp.einsum('bhtk,bhsk,bhtsk->bhts', q_, k_, decay)
        intra = jnp.einsum('bhts,bhsv->bhtv', scores, v_)
        k_dec = k_ * jnp.exp(b_last[..., None, :] - b_)
        S = S * jnp.exp(b_last)[..., None] + jnp.einsum('bhsk,bhsv->bhkv', k_dec, v_)
        return S, inter + intra

    S0 = jnp.zeros((B, H, K, V), jnp.float32)
    _, out = lax.scan(step, S0, (qc, kc, vc, bc))
    return out.transpose(1, 0, 3, 2, 4).reshape(B, T, H, V)


def hgrn2_mixer(h, w_in, w_out, lower_bound, norm_w):
    B, T, _ = h.shape
    proj = jnp.einsum('btd,de->bte', h, w_in)
    q, fx, i, z = jnp.split(proj, 4, axis=-1)

    def heads(a):
        return a.reshape(B, T, HG_HEADS, HG_HEAD_DIM).astype(jnp.float32)

    q, fx, i = heads(q), heads(fx), heads(i)
    lb = lower_bound.astype(jnp.float32).reshape(HG_HEADS, HG_HEAD_DIM)
    f = lb + (1.0 - lb) * jax.nn.sigmoid(fx)
    log_f = jnp.log(f)
    k = (1.0 - lb) * jax.nn.sigmoid(-fx)
    o = chunked_gated_recurrence(q, k, i, log_f)
    o = rms_norm(o) * norm_w.astype(jnp.float32)
    o = o.reshape(B, T, BRANCH_WIDTH).astype(h.dtype) * jax.nn.silu(z)
    return jnp.einsum('bte,ed->btd', o, w_out)


def swa_mixer(h, w_in, w_out, sinks):
    B, T, _ = h.shape
    NB = T // SW_BLOCK
    proj = jnp.einsum('btd,de->bte', h, w_in)
    q, k, v, z = jnp.split(proj, [SW_Q_WIDTH, SW_Q_WIDTH + SW_KV_WIDTH, SW_Q_WIDTH + 2 * SW_KV_WIDTH], axis=-1)
    q = q.reshape(B, NB, SW_BLOCK, SW_KV_HEADS, SW_GROUP, SW_HEAD_DIM).transpose(1, 0, 2, 3, 4, 5)
    k = k.reshape(B, T, SW_KV_HEADS, SW_HEAD_DIM)
    v = v.reshape(B, T, SW_KV_HEADS, SW_HEAD_DIM)

    def key_blocks(a):
        prev = jnp.pad(a, ((0, 0), (SW_BLOCK, 0), (0, 0), (0, 0)))[:, :T]
        shp = (B, NB, SW_BLOCK, SW_KV_HEADS, SW_HEAD_DIM)
        kb = jnp.concatenate([prev.reshape(shp), a.reshape(shp)], axis=2)
        return kb.transpose(1, 0, 2, 3, 4)

    kb, vb = key_blocks(k), key_blocks(v)
    dist = jnp.arange(SW_BLOCK)[:, None] + SW_BLOCK - jnp.arange(2 * SW_BLOCK)[None, :]
    band = (dist >= 0) & (dist < SW_WINDOW)
    slopes = alibi_slopes(SW_Q_HEADS).reshape(SW_KV_HEADS, SW_GROUP)
    bias = -slopes[:, :, None, None] * dist.astype(jnp.float32)
    sink = sinks.astype(jnp.float32).reshape(SW_KV_HEADS, SW_GROUP)[None, :, :, None, None]

    def block(args):
        n, qn, kn, vn = args
        s = jnp.einsum('bqhgd,bkhd->bhgqk', qn, kn).astype(jnp.float32) * SW_SCALE + bias
        key_pos = n * SW_BLOCK - SW_BLOCK + jnp.arange(2 * SW_BLOCK)
        valid = band & (key_pos >= 0)[None, :]
        s = jnp.where(valid, s, -jnp.inf)
        m = jnp.maximum(jnp.max(s, axis=-1, keepdims=True), sink)
        p = jnp.exp(s - m)
        denom = jnp.sum(p, axis=-1, keepdims=True) + jnp.exp(sink - m)
        pr = (p / denom).astype(vn.dtype)
        return jnp.einsum('bhgqk,bkhd->bqhgd', pr, vn)

    out = lax.map(block, (jnp.arange(NB), q, kb, vb))
    out = out.transpose(1, 0, 2, 3, 4, 5).reshape(B, T, SW_Q_WIDTH)
    out = out.astype(h.dtype) * jax.nn.silu(z)
    return jnp.einsum('bte,ed->btd', out, w_out)


def setup_inputs(seed: int = 0) -> dict:
    key = jax.random.key(seed)
    ks = jax.random.split(key, 13)
    f32 = jnp.float32

    def nrm(k, shape, s):
        return s * jax.random.normal(k, shape, f32)

    sw_in_width = SW_Q_WIDTH + 2 * SW_KV_WIDTH + BRANCH_WIDTH
    return {
        'x': nrm(ks[0], (BATCH, SEQ, D_MODEL), 1.0),
        'c': nrm(ks[1], (BATCH, D_MODEL), 1.0),
        'ada_w': nrm(ks[2], (DEPTH, D_MODEL, 3 * D_MODEL), ADA_INIT * D_MODEL ** -0.5),
        'ada_b': nrm(ks[3], (DEPTH, 3 * D_MODEL), 0.02),
        'ln_g': 1.0 + nrm(ks[4], (DEPTH, D_MODEL), 0.02),
        'ln_b': nrm(ks[5], (DEPTH, D_MODEL), 0.02),
        'hg_w_in': nrm(ks[6], (N_A, D_MODEL, 4 * BRANCH_WIDTH), D_MODEL ** -0.5),
        'hg_w_out': nrm(ks[7], (N_A, BRANCH_WIDTH, D_MODEL), DEEPNORM_BETA * BRANCH_WIDTH ** -0.5),
        'hg_lb_logits': nrm(ks[8], (N_A + 1, BRANCH_WIDTH), 1.0),
        'hg_norm_w': 1.0 + nrm(ks[9], (N_A, HG_HEAD_DIM), 0.02),
        'sw_w_in': nrm(ks[10], (N_B, D_MODEL, sw_in_width), D_MODEL ** -0.5),
        'sw_w_out': nrm(ks[11], (N_B, SW_Q_WIDTH, D_MODEL), DEEPNORM_BETA * SW_Q_WIDTH ** -0.5),
        'sw_sinks': nrm(ks[12], (N_B, SW_Q_HEADS), 0.5),
    }


def reference(x, c, ada_w, ada_b, ln_g, ln_b, hg_w_in, hg_w_out, hg_lb_logits, hg_norm_w,
              sw_w_in, sw_w_out, sw_sinks):
    lower_bounds = jnp.cumsum(jax.nn.softmax(hg_lb_logits.astype(jnp.float32), axis=0), axis=0)
    c_act = jax.nn.silu(c)
    for layer in range(DEPTH):
        mod = jnp.einsum('bd,de->be', c_act, ada_w[layer]) + ada_b[layer]
        shift, scale, gate = jnp.split(mod[:, None, :], 3, axis=-1)
        h = x * (1.0 + scale) + shift
        j = layer // N_MIXERS
        if layer % N_MIXERS == 0:
            y = hgrn2_mixer(h, hg_w_in[j], hg_w_out[j], lower_bounds[j], hg_norm_w[j])
        else:
            y = swa_mixer(h, sw_w_in[j], sw_w_out[j], sw_sinks[j])
        x = layer_norm(DEEPNORM_ALPHA * x + (1.0 + gate) * y, ln_g[layer], ln_b[layer])
    return x
```

```cpp
#include <hip/hip_runtime.h>
#include <hip/hip_cooperative_groups.h>
#include <cstdio>
#include <cstdint>
namespace cg = cooperative_groups;
namespace pg8 {
#define PG8_LAS __attribute__((address_space(3)))
typedef unsigned short bf16_t;
typedef short bf16x8 __attribute__((ext_vector_type(8)));
typedef float f32x4 __attribute__((ext_vector_type(4)));
typedef unsigned u32x4 __attribute__((ext_vector_type(4)));
constexpr int BM = 256, BK = 64, HALF = 128, HTB = HALF * BK * 2  , STAGE_BYTES = 8 * HTB, NXCD = 8, WGM = 8;

__host__ __device__ __forceinline__ int lds_byte(int r, int c) { const int st = (r >> 4) * 2 + (c >> 5), rr = r & 15, cc = c & 31, ob = rr * 64 + cc * 2; return st * 1024 + (ob ^ (((ob >> 9) & 1) << 5)); }
__host__ __device__ __forceinline__ void stage_rc(int b, int& R, int& C) { const int st = b / 1024, sb = b % 1024, swz = sb ^ (((sb >> 9) & 1) << 5); R = (st >> 1) * 16 + swz / 64; C = (st & 1) * 32 + (swz % 64) / 2; }
__host__ __device__ __forceinline__ int perm32(int rho) { const int n = rho >> 4, i = rho & 15; return 8 * (i >> 2) + 4 * n + (i & 3); }

struct Unit { int pm, pn; };
struct Gemm { const bf16_t* A; const bf16_t* Bt; int M, N, K; };

struct StaticOrder {
    int nM, nN, nwg, G, c;
    __host__ __device__ void init(int M, int N, int G_, int c_) { nM = M / BM; nN = N / BM; nwg = nM * nN; G = G_; c = c_; }
    __host__ __device__ bool next(int i, Unit& u) const {
        const long L = (long)i * G + c; if (L >= nwg) return false;
        int wgid = (int)L; { const int q = nwg / NXCD, r = nwg % NXCD, xcd = wgid % NXCD, off = wgid / NXCD; wgid = (xcd < r ? xcd * (q + 1) : r * (q + 1) + (xcd - r) * q) + off; }
        const int nig = WGM * nN, gid = wgid / nig, fm = gid * WGM, gsz = (nM - fm) < WGM ? (nM - fm) : WGM;
        u.pm = fm + ((wgid % nig) % gsz); u.pn = (wgid % nig) / gsz; return true;
    }
    __device__ __forceinline__ void a_ready(const Unit&) const {}
    __device__ __forceinline__ void done(const Unit&) const {}
};

__device__ __forceinline__ unsigned cvt_pk_bf16(float lo, float hi) { unsigned r; asm volatile("v_cvt_pk_bf16_f32 %0, %1, %2" : "=v"(r) : "v"(lo), "v"(hi)); return r; }
typedef float f32x2 __attribute__((ext_vector_type(2)));
template <class Epi, class Sched, bool ALIGN_EPI = false, bool SP2 = false>
__device__ __forceinline__ void gemm_phase(PG8_LAS unsigned char* lds, const Gemm g, const Sched& S, const Epi& E) {
    const int tid = threadIdx.x, wid = __builtin_amdgcn_readfirstlane(tid >> 6), lane = tid & 63, wr = wid >> 2, wc = wid & 3, fr = lane & 15, fq = lane >> 4;
    const int K = g.K, nt = K / BK;
    unsigned voffA[2], voffB[2];
#pragma unroll
    for (int i = 0; i < 2; ++i) { int R, C; stage_rc(tid * 16 + i * 8192, R, C); const int Rb = Epi::PERM ? ((R & ~31) + perm32(R & 31)) : R;
        voffA[i] = (unsigned)(R * K + C) * 2u; voffB[i] = (unsigned)(Rb * K + C) * 2u; }
    const size_t kstep = (size_t)(BK * 2);
    const size_t hstep = (size_t)HALF * K * 2;
    const size_t tstep = 2 * hstep;
    const unsigned ldsw = (unsigned)wid * 1024u;
    const int aoff = lds_byte(wr * 64 + fr, fq * 8), boff = lds_byte(wc * 32 + fr, fq * 8);
#define PG8_SA(b, h) (((b) * 2 + (h)) * HTB)
#define PG8_SB(b, h) ((4 + (b) * 2 + (h)) * HTB)
#define PG8_STAGE(bufoff, gbase, voff) do { _Pragma("unroll") for (int _i = 0; _i < 2; ++_i) \
        __builtin_amdgcn_global_load_lds((const unsigned*)((const char*)(gbase) + (voff)[_i]), (PG8_LAS unsigned*)(lds + (bufoff) + ldsw + _i * 8192), 16, 0, 0); } while (0)
#define PG8_LDA(dst, b, h) do { _Pragma("unroll") for (int m = 0; m < 4; ++m) _Pragma("unroll") for (int k = 0; k < 2; ++k) dst[m][k] = *(const PG8_LAS bf16x8*)(lds + PG8_SA(b, h) + aoff + m * 2048 + k * 1024); } while (0)
#define PG8_LDB(dst, b, h) do { _Pragma("unroll") for (int n = 0; n < 2; ++n) _Pragma("unroll") for (int k = 0; k < 2; ++k) dst[n][k] = *(const PG8_LAS bf16x8*)(lds + PG8_SB(b, h) + boff + n * 2048 + k * 1024); } while (0)
#define PG8_MMA(ai, bj, At, Bt) do { __builtin_amdgcn_s_setprio(1); _Pragma("unroll") for (int m = 0; m < 4; ++m) _Pragma("unroll") for (int n = 0; n < 2; ++n) _Pragma("unroll") for (int k = 0; k < 2; ++k) \
        acc[ai][bj][m][n] = __builtin_amdgcn_mfma_f32_16x16x32_bf16(Bt[n][k], At[m][k], acc[ai][bj][m][n], 0, 0, 0); __builtin_amdgcn_s_setprio(0); } while (0)
#define PG8_WAIT_V(n) asm volatile("s_waitcnt vmcnt(" #n ")" ::: "memory")
#define PG8_WAIT_L(n) asm volatile("s_waitcnt lgkmcnt(" #n ")" ::: "memory")
#define PG8_BAR __builtin_amdgcn_s_barrier()
#define PG8_SCHED __builtin_amdgcn_sched_barrier(0)
    Unit cur, nxt; int ui = 0;
    if (!S.next(0, cur)) return;
    f32x4 acc[2][2][4][2];
#pragma unroll
    for (int a = 0; a < 2; ++a)
#pragma unroll
        for (int b = 0; b < 2; ++b)
#pragma unroll
            for (int m = 0; m < 4; ++m)
#pragma unroll
                for (int n = 0; n < 2; ++n) acc[a][b][m][n] = (f32x4){0.f, 0.f, 0.f, 0.f};
    bf16x8 At[4][2], B0[2][2], B1[2][2];
    const char* cA = (const char*)g.A + (size_t)cur.pm * tstep; const char* cB = (const char*)g.Bt + (size_t)cur.pn * tstep;
    S.a_ready(cur);
    if constexpr (SP2) {
        PG8_STAGE(PG8_SB(0, 0), cB, voffB); PG8_STAGE(PG8_SB(0, 1), cB + hstep, voffB); PG8_STAGE(PG8_SA(0, 0), cA, voffA); PG8_STAGE(PG8_SA(0, 1), cA + hstep, voffA);
        if (wr == 1) PG8_BAR;
        PG8_WAIT_V(2); PG8_BAR;
        PG8_STAGE(PG8_SB(1, 0), cB + kstep, voffB); PG8_STAGE(PG8_SA(1, 0), cA + kstep, voffA); PG8_STAGE(PG8_SB(1, 1), cB + hstep + kstep, voffB);
        PG8_WAIT_V(6); PG8_BAR;
    } else {
        PG8_STAGE(PG8_SB(0, 0), cB, voffB); PG8_STAGE(PG8_SA(0, 0), cA, voffA); PG8_STAGE(PG8_SB(0, 1), cB + hstep, voffB); PG8_STAGE(PG8_SA(0, 1), cA + hstep, voffA);
        if (wr == 1) PG8_BAR;
        PG8_WAIT_V(4); PG8_BAR;
        PG8_STAGE(PG8_SB(1, 0), cB + kstep, voffB); PG8_STAGE(PG8_SA(1, 0), cA + kstep, voffA); PG8_STAGE(PG8_SB(1, 1), cB + hstep + kstep, voffB);
        PG8_WAIT_V(6); PG8_BAR;
    }
    for (;;) {
        const bool has_next = S.next(ui + 1, nxt);
        const char* nA = has_next ? (const char*)g.A + (size_t)nxt.pm * tstep : cA; const char* nB = has_next ? (const char*)g.Bt + (size_t)nxt.pn * tstep : cB;
        for (int t = 0; t < nt; t += 2) {
            const bool last = (t == nt - 2);
            const char* a1 = cA + (size_t)(t + 1) * kstep;
            const char* a2 = last ? nA : cA + (size_t)(t + 2) * kstep; const char* b2 = last ? nB : cB + (size_t)(t + 2) * kstep;
            const char* a3 = a2 + kstep; const char* b3 = b2 + kstep;
            if (last && has_next) S.a_ready(nxt);
            if constexpr (SP2) {
            PG8_LDB(B0, 0, 0); PG8_LDB(B1, 0, 1); PG8_SCHED; PG8_LDA(At, 0, 0); PG8_STAGE(PG8_SA(1, 1), a1 + hstep, voffA);
            PG8_WAIT_V(8); PG8_WAIT_L(0); PG8_BAR; PG8_MMA(0, 0, At, B0); PG8_MMA(0, 1, At, B1); PG8_BAR; PG8_SCHED;
            PG8_LDA(At, 0, 1); PG8_STAGE(PG8_SB(0, 0), b2, voffB); PG8_STAGE(PG8_SB(0, 1), b2 + hstep, voffB); PG8_STAGE(PG8_SA(0, 0), a2, voffA);
            PG8_WAIT_V(8); PG8_WAIT_L(0); PG8_BAR; PG8_MMA(1, 0, At, B0); PG8_MMA(1, 1, At, B1); PG8_BAR; PG8_SCHED;
            PG8_LDB(B0, 1, 0); PG8_LDB(B1, 1, 1); PG8_SCHED; PG8_LDA(At, 1, 0); PG8_STAGE(PG8_SA(0, 1), a2 + hstep, voffA);
            PG8_WAIT_V(8); PG8_WAIT_L(0); PG8_BAR; PG8_MMA(0, 0, At, B0); PG8_MMA(0, 1, At, B1); PG8_BAR; PG8_SCHED;
            PG8_LDA(At, 1, 1); PG8_STAGE(PG8_SB(1, 0), b3, voffB); PG8_STAGE(PG8_SB(1, 1), b3 + hstep, voffB); PG8_STAGE(PG8_SA(1, 0), a3, voffA);
            PG8_WAIT_V(8); PG8_WAIT_L(0); PG8_BAR; PG8_MMA(1, 0, At, B0); PG8_MMA(1, 1, At, B1); PG8_BAR; PG8_SCHED;
            } else {
            PG8_LDB(B0, 0, 0); PG8_SCHED; PG8_LDA(At, 0, 0); PG8_STAGE(PG8_SA(1, 1), a1 + hstep, voffA);
            PG8_WAIT_L(8); PG8_BAR; PG8_WAIT_L(0); PG8_MMA(0, 0, At, B0); PG8_BAR; PG8_SCHED;
            PG8_LDB(B1, 0, 1); PG8_STAGE(PG8_SB(0, 0), b2, voffB);
            PG8_BAR; PG8_WAIT_L(0); PG8_MMA(0, 1, At, B1); PG8_BAR;
            PG8_LDA(At, 0, 1); PG8_STAGE(PG8_SA(0, 0), a2, voffA);
            PG8_BAR; PG8_WAIT_L(0); PG8_MMA(1, 0, At, B0); PG8_BAR; PG8_SCHED;
            PG8_STAGE(PG8_SB(0, 1), b2 + hstep, voffB);
            PG8_WAIT_V(6); PG8_BAR; PG8_MMA(1, 1, At, B1); PG8_BAR;
            PG8_LDB(B0, 1, 0); PG8_SCHED; PG8_LDA(At, 1, 0); PG8_STAGE(PG8_SA(0, 1), a2 + hstep, voffA);
            PG8_WAIT_L(8); PG8_BAR; PG8_WAIT_L(0); PG8_MMA(0, 0, At, B0); PG8_BAR; PG8_SCHED;
            PG8_LDB(B1, 1, 1); PG8_STAGE(PG8_SB(1, 0), b3, voffB);
            PG8_BAR; PG8_WAIT_L(0); PG8_MMA(0, 1, At, B1); PG8_BAR;
            PG8_LDA(At, 1, 1); PG8_STAGE(PG8_SA(1, 0), a3, voffA);
            PG8_BAR; PG8_WAIT_L(0); PG8_MMA(1, 0, At, B0); PG8_BAR; PG8_SCHED;
            PG8_STAGE(PG8_SB(1, 1), b3 + hstep, voffB);
            PG8_WAIT_V(6); PG8_BAR; PG8_MMA(1, 1, At, B1); PG8_BAR;
            }
        }
        if constexpr (ALIGN_EPI) { if (wr == 0) PG8_BAR; }
        if constexpr (!Epi::AFTER_DRAIN) { E(acc, cur, wr, wc, fr, fq); S.done(cur); }
        if (!has_next) break;
#pragma unroll
        for (int a = 0; a < 2; ++a)
#pragma unroll
            for (int b = 0; b < 2; ++b)
#pragma unroll
                for (int m = 0; m < 4; ++m)
#pragma unroll
                    for (int n = 0; n < 2; ++n) acc[a][b][m][n] = (f32x4){0.f, 0.f, 0.f, 0.f};
        cur = nxt; cA = nA; cB = nB; ++ui;
        if constexpr (ALIGN_EPI) { if (wr == 1) PG8_BAR; }
    }
    PG8_WAIT_V(0);
    if constexpr (!ALIGN_EPI) { if (wr == 0) PG8_BAR; }
    PG8_BAR;
    if constexpr (Epi::AFTER_DRAIN) { E.fused(acc, cur, wr, wc, fr, fq, lds, wid, lane); S.done(cur); }
#undef PG8_SA
#undef PG8_SB
#undef PG8_STAGE
#undef PG8_LDA
#undef PG8_LDB
#undef PG8_MMA
#undef PG8_WAIT_V
#undef PG8_WAIT_L
#undef PG8_BAR
#undef PG8_SCHED
}
}

#define LAS __attribute__((address_space(3)))
typedef unsigned short bf16;
typedef unsigned v4u __attribute__((ext_vector_type(4)));
typedef unsigned v2u __attribute__((ext_vector_type(2)));
typedef float f32x4 __attribute__((ext_vector_type(4)));
typedef float f32x16 __attribute__((ext_vector_type(16)));
typedef short bf16x8 __attribute__((ext_vector_type(8)));
typedef float f32x2_t __attribute__((ext_vector_type(2)));
typedef __bf16 bf16x2_t __attribute__((ext_vector_type(2)));
typedef _Float16 h16x2_t __attribute__((ext_vector_type(2)));
__device__ __forceinline__ unsigned pk2(float lo, float hi) { f32x2_t v = {lo, hi}; bf16x2_t b = __builtin_convertvector(v, bf16x2_t); return __builtin_bit_cast(unsigned, b); }
__device__ __forceinline__ unsigned pkh2(float lo, float hi) { h16x2_t h = {(_Float16)lo, (_Float16)hi}; return __builtin_bit_cast(unsigned, h); }
__device__ __forceinline__ float bf2f(unsigned short u) { return __uint_as_float((unsigned)u << 16); }
__device__ __forceinline__ float bflo(unsigned u) { return __uint_as_float(u << 16); }
__device__ __forceinline__ float bfhi(unsigned u) { return __uint_as_float(u & 0xffff0000u); }
__device__ __forceinline__ float sigmoidf_(float x) { return __builtin_amdgcn_rcpf(1.0f + __expf(-x)); }
__device__ __forceinline__ bf16x8 pack8(f32x4 a, f32x4 b) { v4u w; w.x = pk2(a[0], a[1]); w.y = pk2(a[2], a[3]); w.z = pk2(b[0], b[1]); w.w = pk2(b[2], b[3]); return __builtin_bit_cast(bf16x8, w); }
#define MFMA16(a, b, c) __builtin_amdgcn_mfma_f32_16x16x32_bf16((a), (b), (c), 0, 0, 0)
#define MFMA32(a, b, c) __builtin_amdgcn_mfma_f32_32x32x16_bf16((a), (b), (c), 0, 0, 0)
#define LDS_WAIT() asm volatile("s_waitcnt lgkmcnt(0)" ::: "memory")

constexpr int BATCH = 8, T = 2048, D = 1024, W = 2048, M = BATCH * T;
constexpr int N1 = 4 * W;
constexpr int KVW = 256, N3 = W + 2 * KVW + W;
constexpr float ALPHA = 1.41421356237309515f;
constexpr float LOG2E = 1.4426950408889634f;
constexpr float QSCALE = 0.125f * LOG2E;
constexpr int NWAVES = 8, NTHR = 512;
constexpr int LDS_BYTES = 147456;

constexpr size_t MiB = 1u << 20;
constexpr size_t WS_MOD = 4096;
constexpr size_t WS_WA = 1 * MiB;
constexpr size_t WS_WO0 = 17 * MiB;
constexpr size_t WS_H = 21 * MiB;
constexpr size_t WS_Q = 53 * MiB;
constexpr size_t WS_F = 117 * MiB;
constexpr size_t WS_V = 181 * MiB;
constexpr size_t WS_WO1 = 245 * MiB;

__device__ __forceinline__ void transpose_item(const float* Wm, int K, int N, bf16* WT, LAS float* scr, int item, int lane) {
    const int nblk = N / 32, kb = item / nblk, nb = item % nblk, k0 = 64 * kb, n0 = 32 * nb;
#pragma unroll 8
    for (int i = 0; i < 32; ++i) { const int kk = 2 * i + (lane >> 5); scr[kk * 33 + (lane & 31)] = Wm[(size_t)(k0 + kk) * N + n0 + (lane & 31)]; }
    LDS_WAIT();
    const int c = lane & 7;
#pragma unroll
    for (int j = 0; j < 4; ++j) { const int n = (lane >> 3) + 8 * j; const LAS float* s = scr + (8 * c) * 33 + n;
        v4u o; o.x = pk2(s[0 * 33], s[1 * 33]); o.y = pk2(s[2 * 33], s[3 * 33]); o.z = pk2(s[4 * 33], s[5 * 33]); o.w = pk2(s[6 * 33], s[7 * 33]);
        *(v4u*)(WT + (size_t)(n0 + n) * K + k0 + 8 * c) = o; }
    LDS_WAIT();
}

__device__ __forceinline__ float wave_sum(float v) {
#pragma unroll
    for (int o = 1; o < 64; o <<= 1) v += __shfl_xor(v, o);
    return v;
}

__device__ __forceinline__ void mod_item(const float* c, const float* ada_w, const float* ada_b, float* mod, int item, LAS float* red, int tid) {
    const int l = item / 48, eb = item % 48, wave = tid >> 6, lane = tid & 63, e = eb * 64 + lane;
    float sc0[8], sc1[8], acc[8];
#pragma unroll
    for (int b = 0; b < 8; ++b) { float v = c[b * 1024 + 128 * wave + lane]; sc0[b] = v * sigmoidf_(v); v = c[b * 1024 + 128 * wave + 64 + lane]; sc1[b] = v * sigmoidf_(v); acc[b] = 0.f; }
    const float* wp = ada_w + (size_t)l * 1024 * 3072 + (size_t)(128 * wave) * 3072 + e;
#pragma unroll 8
    for (int dd = 0; dd < 64; ++dd) { const float wv = wp[(size_t)dd * 3072];
#pragma unroll
        for (int b = 0; b < 8; ++b) acc[b] += __shfl(sc0[b], dd) * wv; }
    wp += (size_t)64 * 3072;
#pragma unroll 8
    for (int dd = 0; dd < 64; ++dd) { const float wv = wp[(size_t)dd * 3072];
#pragma unroll
        for (int b = 0; b < 8; ++b) acc[b] += __shfl(sc1[b], dd) * wv; }
#pragma unroll
    for (int b = 0; b < 8; ++b) red[(wave * 8 + b) * 64 + lane] = acc[b];
    __syncthreads();
    { const int b = tid >> 6; float s = 0.f;
#pragma unroll
      for (int w = 0; w < 8; ++w) s += red[(w * 8 + b) * 64 + lane];
      mod[(l * 8 + b) * 3072 + e] = s + ada_b[l * 3072 + e]; }
    __syncthreads();
}

__device__ __forceinline__ void hmod_rows(const float* x, const float* modl, bf16* H, int gw, int NGW, int lane) {
    for (int m = gw; m < M; m += NGW) {
        const int b = m >> 11;
        const f32x4* xr = (const f32x4*)(x + (size_t)m * D) + lane;
        const f32x4* sh = (const f32x4*)(modl + b * 3072) + lane;
        const f32x4* sc = (const f32x4*)(modl + b * 3072 + 1024) + lane;
        v2u* o = (v2u*)(H + (size_t)m * D) + lane;
#pragma unroll
        for (int j = 0; j < 4; ++j) { const f32x4 v = xr[64 * j], s = sc[64 * j], t = sh[64 * j]; const f32x4 h = v * (1.0f + s) + t;
            v2u w; w.x = pk2(h[0], h[1]); w.y = pk2(h[2], h[3]); o[64 * j] = w; }
    }
}

__device__ __forceinline__ void ln_rows(const float* u, const float* g, const float* bt, float* xo, const float* modl, bf16* H, int gw, int NGW, int lane) {
    f32x4 gv[4], bv[4];
#pragma unroll
    for (int j = 0; j < 4; ++j) { gv[j] = ((const f32x4*)g)[64 * j + lane]; bv[j] = ((const f32x4*)bt)[64 * j + lane]; }
    for (int m = gw; m < M; m += NGW) {
        const f32x4* ur = (const f32x4*)(u + (size_t)m * D) + lane;
        f32x4 v[4]; float s = 0.f;
#pragma unroll
        for (int j = 0; j < 4; ++j) { v[j] = ur[64 * j]; s += (v[j][0] + v[j][1]) + (v[j][2] + v[j][3]); }
        const float mean = wave_sum(s) * (1.0f / D); float s2 = 0.f;
#pragma unroll
        for (int j = 0; j < 4; ++j) { v[j] = v[j] - mean; s2 += (v[j][0] * v[j][0] + v[j][1] * v[j][1]) + (v[j][2] * v[j][2] + v[j][3] * v[j][3]); }
        const float rstd = 1.0f / sqrtf(wave_sum(s2) * (1.0f / D) + 1e-5f);
        f32x4* xr = (f32x4*)(xo + (size_t)m * D) + lane;
#pragma unroll
        for (int j = 0; j < 4; ++j) { v[j] = v[j] * rstd * gv[j] + bv[j]; xr[64 * j] = v[j]; }
        if (H) {
            const int b = m >> 11;
            const f32x4* sh = (const f32x4*)(modl + b * 3072) + lane;
            const f32x4* sc = (const f32x4*)(modl + b * 3072 + 1024) + lane;
            v2u* o = (v2u*)(H + (size_t)m * D) + lane;
#pragma unroll
            for (int j = 0; j < 4; ++j) { const f32x4 h = v[j] * (1.0f + sc[64 * j]) + sh[64 * j]; v2u w; w.x = pk2(h[0], h[1]); w.y = pk2(h[2], h[3]); o[64 * j] = w; }
        }
    }
}

typedef pg8::f32x4 pf4;
struct EpiL0 {
    static constexpr bool PERM = true, AFTER_DRAIN = false;
    bf16* Q; bf16* F; bf16* V; bf16* SZ; const float* lbl;
    __device__ __forceinline__ void operator()(const pf4 (&acc)[2][2][4][2], const pg8::Unit& u, int wr, int wc, int fr, int fq) const {
        const int type = u.pn >> 3, colt = (u.pn & 7) * 256;
        const int row0 = u.pm * 256 + wr * 64 + fr, col0 = colt + wc * 32 + 8 * fq;
        bf16* base = type == 0 ? Q : (type == 1 ? F : (type == 2 ? V : SZ));
        float lb[2][8];
#pragma unroll
        for (int bj = 0; bj < 2; ++bj)
#pragma unroll
            for (int e = 0; e < 8; ++e) lb[bj][e] = 0.f;
        if (type == 1) {
#pragma unroll
            for (int bj = 0; bj < 2; ++bj)
#pragma unroll
                for (int e = 0; e < 8; ++e) { const int c = col0 + bj * 128 + e; lb[bj][e] = __builtin_amdgcn_rcpf(1.0f + __expf(lbl[2048 + c] - lbl[c])); }
        }
#pragma unroll
        for (int ai = 0; ai < 2; ++ai)
#pragma unroll
            for (int m = 0; m < 4; ++m) { bf16* rowp = base + (size_t)(row0 + ai * 128 + m * 16) * 2048 + col0;
#pragma unroll
                for (int bj = 0; bj < 2; ++bj) { float v[8];
#pragma unroll
                    for (int e = 0; e < 4; ++e) { v[e] = acc[ai][bj][m][0][e]; v[4 + e] = acc[ai][bj][m][1][e]; }
                    v4u w;
                    if (type == 1) {
#pragma unroll
                        for (int e = 0; e < 8; ++e) v[e] = lb[bj][e] + (1.0f - lb[bj][e]) * sigmoidf_(v[e]);
                        w.x = pkh2(v[0], v[1]); w.y = pkh2(v[2], v[3]); w.z = pkh2(v[4], v[5]); w.w = pkh2(v[6], v[7]);
                    } else {
                        if (type == 3) {
#pragma unroll
                            for (int e = 0; e < 8; ++e) v[e] = v[e] * sigmoidf_(v[e]);
                        }
                        w.x = pk2(v[0], v[1]); w.y = pk2(v[2], v[3]); w.z = pk2(v[4], v[5]); w.w = pk2(v[6], v[7]);
                    }
                    *(v4u*)(rowp + bj * 128) = w; } }
    }
};
struct EpiL1 {
    static constexpr bool PERM = true, AFTER_DRAIN = false;
    bf16* Q; bf16* K; bf16* V; bf16* SZ;
    __device__ __forceinline__ void operator()(const pf4 (&acc)[2][2][4][2], const pg8::Unit& u, int wr, int wc, int fr, int fq) const {
        const int pn = u.pn;
        bf16* base; int ldc, colt; float sc = 1.0f; bool act = false;
        if (pn < 8) { base = Q; ldc = 2048; colt = pn * 256; sc = QSCALE; }
        else if (pn == 8) { base = K; ldc = 256; colt = 0; }
        else if (pn == 9) { base = V; ldc = 256; colt = 0; }
        else { base = SZ; ldc = 2048; colt = (pn - 10) * 256; act = true; }
        const int row0 = u.pm * 256 + wr * 64 + fr, col0 = colt + wc * 32 + 8 * fq;
#pragma unroll
        for (int ai = 0; ai < 2; ++ai)
#pragma unroll
            for (int m = 0; m < 4; ++m) { bf16* rowp = base + (size_t)(row0 + ai * 128 + m * 16) * ldc + col0;
#pragma unroll
                for (int bj = 0; bj < 2; ++bj) { float v[8];
#pragma unroll
                    for (int e = 0; e < 4; ++e) { v[e] = acc[ai][bj][m][0][e] * sc; v[4 + e] = acc[ai][bj][m][1][e] * sc; }
                    if (act) {
#pragma unroll
                        for (int e = 0; e < 8; ++e) v[e] = v[e] * sigmoidf_(v[e]);
                    }
                    v4u w; w.x = pk2(v[0], v[1]); w.y = pk2(v[2], v[3]); w.z = pk2(v[4], v[5]); w.w = pk2(v[6], v[7]);
                    *(v4u*)(rowp + bj * 128) = w; } }
    }
};
struct EpiRes {
    static constexpr bool PERM = false, AFTER_DRAIN = false;
    const float* xin; const float* gate; float* out;
    __device__ __forceinline__ void operator()(const pf4 (&acc)[2][2][4][2], const pg8::Unit& u, int wr, int wc, int fr, int fq) const {
        const int row0 = u.pm * 256 + wr * 64 + fr, col0 = u.pn * 256 + wc * 32 + 4 * fq, b = (u.pm * 256) >> 11;
        pf4 gt[2][2];
#pragma unroll
        for (int bj = 0; bj < 2; ++bj)
#pragma unroll
            for (int n = 0; n < 2; ++n) gt[bj][n] = *(const pf4*)(gate + b * 3072 + col0 + bj * 128 + n * 16) + 1.0f;
#pragma unroll
        for (int ai = 0; ai < 2; ++ai)
#pragma unroll
            for (int m = 0; m < 4; ++m) { const size_t off = (size_t)(row0 + ai * 128 + m * 16) * D + col0;
#pragma unroll
                for (int bj = 0; bj < 2; ++bj)
#pragma unroll
                    for (int n = 0; n < 2; ++n) { const pf4 xv = *(const pf4*)(xin + off + bj * 128 + n * 16);
                        *(pf4*)(out + off + bj * 128 + n * 16) = xv * ALPHA + gt[bj][n] * acc[ai][bj][m][n]; } }
    }
};

__device__ __forceinline__ void recur_item(int bh, const bf16* Q, const bf16* Fh, const bf16* V, const bf16* SZ, const float* normw, bf16* OG, LAS unsigned char* lds, int tid) {
    const int b = bh >> 4, h = bh & 15;
    const int wave = tid >> 6, lane = tid & 63, r16 = lane & 15, quad = lane >> 4;
    LAS unsigned char* qt = lds;
    LAS unsigned char* kt = lds + 8704;
    LAS unsigned char* kdT = lds + 17408;
    LAS unsigned char* vT = lds + 25600;
    LAS float* plast = (LAS float*)(lds + 33792);
    LAS float* tot = (LAS float*)(lds + 34304);
    LAS float* ssq = (LAS float*)(lds + 36352);
    const int k = tid & 127, g = tid >> 7, vs = 16 * wave;
    f32x4 S[8];
#pragma unroll
    for (int i = 0; i < 8; ++i) S[i] = (f32x4){0.f, 0.f, 0.f, 0.f};
    const float nw = normw[vs + r16];
    for (int n = 0; n < T / 32; ++n) {
        const size_t rowbase = (size_t)b * T + (size_t)n * 32;
        float f[8], qv[8], p[8]; unsigned vv[8];
        const size_t gofs = (rowbase + 8 * g) * W + h * 128 + k;
#pragma unroll
        for (int j = 0; j < 8; ++j) { f[j] = (float)__builtin_bit_cast(_Float16, Fh[gofs + (size_t)j * W]); qv[j] = bf2f(Q[gofs + (size_t)j * W]); vv[j] = V[gofs + (size_t)j * W]; }
        float run = 1.0f;
#pragma unroll
        for (int j = 0; j < 8; ++j) { run *= f[j]; p[j] = run; }
        tot[g * 128 + k] = run;
        { v4u w; w.x = vv[0] | (vv[1] << 16); w.y = vv[2] | (vv[3] << 16); w.z = vv[4] | (vv[5] << 16); w.w = vv[6] | (vv[7] << 16); *(LAS v4u*)(vT + k * 64 + g * 16) = w; }
        __syncthreads();
        float pre = 1.0f, all = 1.0f;
#pragma unroll
        for (int gg = 0; gg < 4; ++gg) { const float tg = tot[gg * 128 + k]; if (gg < g) pre *= tg; all *= tg; }
        float kd[8];
#pragma unroll
        for (int j = 0; j < 8; ++j) { const float P = pre * p[j]; const float qtl = qv[j] * P; const float ktl = (1.0f - f[j]) * __builtin_amdgcn_rcpf(P); kd[j] = ktl * all;
            *(LAS unsigned short*)(qt + (8 * g + j) * 272 + k * 2) = (unsigned short)(pk2(qtl, 0.f) & 0xffffu);
            *(LAS unsigned short*)(kt + (8 * g + j) * 272 + k * 2) = (unsigned short)(pk2(ktl, 0.f) & 0xffffu); }
        { v4u w; w.x = pk2(kd[0], kd[1]); w.y = pk2(kd[2], kd[3]); w.z = pk2(kd[4], kd[5]); w.w = pk2(kd[6], kd[7]); *(LAS v4u*)(kdT + k * 64 + g * 16) = w; }
        if (g == 0) plast[k] = all;
        __syncthreads();
        f32x4 o[2]; o[0] = (f32x4){0.f, 0.f, 0.f, 0.f}; o[1] = o[0];
#pragma unroll
        for (int kk = 0; kk < 4; ++kk) {
            const bf16x8 Sb = pack8(S[2 * kk], S[2 * kk + 1]);
#pragma unroll
            for (int tt = 0; tt < 2; ++tt) {
                const LAS unsigned char* ap = qt + (16 * tt + r16) * 272 + (32 * kk + 4 * quad) * 2;
                const v2u lo = *(const LAS v2u*)ap, hi = *(const LAS v2u*)(ap + 32);
                v4u aw; aw.x = lo.x; aw.y = lo.y; aw.z = hi.x; aw.w = hi.y;
                o[tt] = MFMA16(__builtin_bit_cast(bf16x8, aw), Sb, o[tt]);
            }
        }
        f32x4 sc[2][2];
#pragma unroll
        for (int st = 0; st < 2; ++st)
#pragma unroll
            for (int tt = 0; tt < 2; ++tt) {
                f32x4 a = (f32x4){0.f, 0.f, 0.f, 0.f};
                if (!(st == 1 && tt == 0)) {
#pragma unroll
                    for (int kk = 0; kk < 4; ++kk) {
                        const bf16x8 A = *(const LAS bf16x8*)(kt + (16 * st + r16) * 272 + (32 * kk + 8 * quad) * 2);
                        const bf16x8 B = *(const LAS bf16x8*)(qt + (16 * tt + r16) * 272 + (32 * kk + 8 * quad) * 2);
                        a = MFMA16(A, B, a);
                    }
#pragma unroll
                    for (int j = 0; j < 4; ++j) { const int s = 16 * st + 4 * quad + j, t = 16 * tt + r16; if (s > t) a[j] = 0.f; }
                }
                sc[st][tt] = a;
            }
        {
            const LAS unsigned char* bp = vT + (vs + r16) * 64 + (4 * quad) * 2;
            const v2u lo = *(const LAS v2u*)bp, hi = *(const LAS v2u*)(bp + 32);
            v4u bw; bw.x = lo.x; bw.y = lo.y; bw.z = hi.x; bw.w = hi.y;
            const bf16x8 Bv = __builtin_bit_cast(bf16x8, bw);
#pragma unroll
            for (int tt = 0; tt < 2; ++tt) o[tt] = MFMA16(pack8(sc[0][tt], sc[1][tt]), Bv, o[tt]);
        }
        {
            const bf16x8 Bv = *(const LAS bf16x8*)(vT + (vs + r16) * 64 + quad * 16);
#pragma unroll
            for (int i = 0; i < 8; ++i) {
                const f32x4 pl = *(const LAS f32x4*)(plast + 16 * i + 4 * quad);
                const bf16x8 Ak = *(const LAS bf16x8*)(kdT + (16 * i + r16) * 64 + quad * 16);
                S[i] = MFMA16(Ak, Bv, S[i] * pl);
            }
        }
        float part[2][4];
#pragma unroll
        for (int tt = 0; tt < 2; ++tt)
#pragma unroll
            for (int j = 0; j < 4; ++j) { float v = o[tt][j] * o[tt][j]; v += __shfl_xor(v, 1); v += __shfl_xor(v, 2); v += __shfl_xor(v, 4); v += __shfl_xor(v, 8); part[tt][j] = v; }
        if (r16 == 0) {
#pragma unroll
            for (int tt = 0; tt < 2; ++tt)
#pragma unroll
                for (int j = 0; j < 4; ++j) ssq[wave * 32 + 16 * tt + 4 * quad + j] = part[tt][j];
        }
        __syncthreads();
#pragma unroll
        for (int tt = 0; tt < 2; ++tt)
#pragma unroll
            for (int j = 0; j < 4; ++j) { const int t = 16 * tt + 4 * quad + j; float s = 0.f;
#pragma unroll
                for (int w = 0; w < 8; ++w) s += ssq[w * 32 + t];
                const float rs = 1.0f / sqrtf(s * (1.0f / 128.0f) + 1e-6f);
                const size_t idx = (rowbase + t) * W + h * 128 + vs + r16;
                OG[idx] = (unsigned short)(pk2(o[tt][j] * rs * nw * bf2f(SZ[idx]), 0.f) & 0xffffu); }
    }
    __syncthreads();
}

__device__ __forceinline__ int crow(int r, int hi) { return (r & 3) + 8 * (r >> 2) + 4 * hi; }
__device__ __forceinline__ void attn_item(int item, const bf16* Q, const bf16* K, const bf16* V, const bf16* SZ, const float* sinks, bf16* AG, LAS unsigned char* lds, int tid) {
    const int blk = item & 15, kvh = (item >> 4) & 3, b = item >> 6;
    const int wave = tid >> 6, lane = tid & 63, r32 = lane & 31, hh = lane >> 5;
    LAS unsigned char* Ks = lds;
    LAS unsigned char* vT = lds + 36864;
    LAS unsigned char* ost = lds + 70656 + wave * 8704;
    const long row0 = (long)b * T + blk * 128 - 128;
#pragma unroll
    for (int p = 0; p < 4; ++p) {
        const int idx = p * 512 + tid, key = idx >> 3, part = idx & 7;
        v4u kv = (v4u){0u, 0u, 0u, 0u}, vv = kv;
        if (blk > 0 || key >= 128) { kv = *(const v4u*)(K + (size_t)(row0 + key) * KVW + kvh * 64 + part * 8); vv = *(const v4u*)(V + (size_t)(row0 + key) * KVW + kvh * 64 + part * 8); }
        *(LAS v4u*)(Ks + key * 144 + part * 16) = kv;
#pragma unroll
        for (int e = 0; e < 8; ++e) { const unsigned wv = vv[e >> 1]; *(LAS unsigned short*)(vT + (part * 8 + e) * 528 + key * 2) = (unsigned short)((e & 1) ? (wv >> 16) : (wv & 0xffffu)); }
    }
    __syncthreads();
    const int hq = kvh * 8 + wave;
    const float slope2 = exp2f(-0.25f * (float)(hq + 1)) * LOG2E, sink2 = sinks[hq] * LOG2E;
    const int rm = r32 - 4 * hh;
    f32x16 cb;
#pragma unroll
    for (int i = 0; i < 16; ++i) cb[i] = slope2 * (float)((i & 3) + 8 * (i >> 2) + 4 * hh);
#pragma unroll 1
    for (int qt = 0; qt < 4; ++qt) {
        const size_t qrow = (size_t)b * T + blk * 128 + 32 * qt + r32;
        bf16x8 qf[4];
#pragma unroll
        for (int s = 0; s < 4; ++s) qf[s] = *(const bf16x8*)(Q + qrow * W + hq * 64 + 16 * s + 8 * hh);
        const float sinkq = sink2 + slope2 * (float)(128 + 32 * qt + r32);
        f32x16 sT[5];
#pragma unroll
        for (int j = 0; j < 5; ++j) {
            f32x16 a;
            const bool ok = (blk > 0) || (qt + j >= 4);
            if (ok) {
                const float sj = slope2 * (float)(32 * (qt + j));
#pragma unroll
                for (int i = 0; i < 16; ++i) a[i] = cb[i] + sj;
#pragma unroll
                for (int s = 0; s < 4; ++s) { const bf16x8 A = *(const LAS bf16x8*)(Ks + (32 * (qt + j) + r32) * 144 + (16 * s + 8 * hh) * 2); a = MFMA32(A, qf[s], a); }
                if (j == 0) {
#pragma unroll
                    for (int i = 0; i < 16; ++i) if (((i & 3) + 8 * (i >> 2)) <= rm) a[i] = -INFINITY;
                }
                if (j == 4) {
#pragma unroll
                    for (int i = 0; i < 16; ++i) if (((i & 3) + 8 * (i >> 2)) > rm) a[i] = -INFINITY;
                }
            } else {
#pragma unroll
                for (int i = 0; i < 16; ++i) a[i] = -INFINITY;
            }
            sT[j] = a;
            __builtin_amdgcn_sched_barrier(0);
        }
        float mx = sinkq;
#pragma unroll
        for (int j = 0; j < 5; ++j)
#pragma unroll
            for (int i = 0; i < 16; ++i) mx = fmaxf(mx, sT[j][i]);
        mx = fmaxf(mx, __shfl_xor(mx, 32));
        float l = 0.f;
#pragma unroll
        for (int j = 0; j < 5; ++j)
#pragma unroll
            for (int i = 0; i < 16; ++i) { const float pe = exp2f(sT[j][i] - mx); sT[j][i] = pe; l += pe; }
        l += __shfl_xor(l, 32); l += exp2f(sinkq - mx);
        const float inv = 1.0f / l;
        f32x16 oT[2];
#pragma unroll
        for (int i = 0; i < 16; ++i) { oT[0][i] = 0.f; oT[1][i] = 0.f; }
#pragma unroll
        for (int j = 0; j < 5; ++j)
#pragma unroll
            for (int s = 0; s < 2; ++s) {
                v4u pw; pw.x = pk2(sT[j][8 * s + 0], sT[j][8 * s + 1]); pw.y = pk2(sT[j][8 * s + 2], sT[j][8 * s + 3]); pw.z = pk2(sT[j][8 * s + 4], sT[j][8 * s + 5]); pw.w = pk2(sT[j][8 * s + 6], sT[j][8 * s + 7]);
                const bf16x8 pb = __builtin_bit_cast(bf16x8, pw);
#pragma unroll
                for (int dt = 0; dt < 2; ++dt) {
                    const LAS unsigned char* ap = vT + (32 * dt + r32) * 528 + (32 * (qt + j) + 16 * s + 4 * hh) * 2;
                    const v2u lo = *(const LAS v2u*)ap, hi = *(const LAS v2u*)(ap + 16);
                    v4u aw; aw.x = lo.x; aw.y = lo.y; aw.z = hi.x; aw.w = hi.y;
                    oT[dt] = MFMA32(__builtin_bit_cast(bf16x8, aw), pb, oT[dt]);
                }
                __builtin_amdgcn_sched_barrier(0);
            }
#pragma unroll
        for (int dt = 0; dt < 2; ++dt)
#pragma unroll
            for (int ig = 0; ig < 4; ++ig) { f32x4 v; v[0] = oT[dt][4 * ig] * inv; v[1] = oT[dt][4 * ig + 1] * inv; v[2] = oT[dt][4 * ig + 2] * inv; v[3] = oT[dt][4 * ig + 3] * inv;
                *(LAS f32x4*)(ost + r32 * 272 + (32 * dt + 8 * ig + 4 * hh) * 4) = v; }
        LDS_WAIT();
#pragma unroll
        for (int it = 0; it < 4; ++it) {
            const int idx = it * 64 + lane, q = idx >> 3, part = idx & 7;
            const f32x4 a0 = *(const LAS f32x4*)(ost + q * 272 + part * 32), a1 = *(const LAS f32x4*)(ost + q * 272 + part * 32 + 16);
            const size_t gi = ((size_t)b * T + blk * 128 + 32 * qt + q) * W + hq * 64 + part * 8;
            const v4u z = *(const v4u*)(SZ + gi);
            v4u w; w.x = pk2(a0[0] * bflo(z.x), a0[1] * bfhi(z.x)); w.y = pk2(a0[2] * bflo(z.y), a0[3] * bfhi(z.y));
            w.z = pk2(a1[0] * bflo(z.z), a1[1] * bfhi(z.z)); w.w = pk2(a1[2] * bflo(z.w), a1[3] * bfhi(z.w));
            *(v4u*)(AG + gi) = w;
        }
        LDS_WAIT();
    }
    __syncthreads();
}

struct Args { const float* in[13]; float* out; unsigned char* ws; };
__global__ void __launch_bounds__(NTHR, 2) fwd_megakernel(Args a) {
    extern __shared__ __attribute__((aligned(16))) unsigned char lds_raw[];
    LAS unsigned char* lds = (LAS unsigned char*)lds_raw;
    cg::grid_group grid = cg::this_grid();
    const int tid = threadIdx.x, lane = tid & 63, wave = __builtin_amdgcn_readfirstlane(tid >> 6);
    const int G = gridDim.x, bx = blockIdx.x;
    const int gw = bx * NWAVES + wave, NGW = G * NWAVES;
    const float* x = a.in[0]; const float* c = a.in[1]; const float* ada_w = a.in[2]; const float* ada_b = a.in[3];
    const float* ln_g = a.in[4]; const float* ln_b = a.in[5]; const float* hg_w_in = a.in[6]; const float* hg_w_out = a.in[7];
    const float* lbl = a.in[8]; const float* hg_nw = a.in[9]; const float* sw_w_in = a.in[10]; const float* sw_w_out = a.in[11]; const float* sinks = a.in[12];
    unsigned char* ws = a.ws;
    float* mod = (float*)(ws + WS_MOD);
    bf16* WA = (bf16*)(ws + WS_WA); bf16* WO0 = (bf16*)(ws + WS_WO0); bf16* WO1 = (bf16*)(ws + WS_WO1);
    bf16* H = (bf16*)(ws + WS_H); bf16* Qb = (bf16*)(ws + WS_Q); bf16* Fb = (bf16*)(ws + WS_F); bf16* Vb = (bf16*)(ws + WS_V);
    float* X1 = (float*)(ws + WS_F); float* U0 = (float*)(ws + WS_V);
    bf16* K1 = (bf16*)(ws + WS_V); bf16* V1 = (bf16*)(ws + WS_V + 8 * MiB);
    bf16* SZ = (bf16*)a.out;
    LAS float* scr = (LAS float*)(lds + wave * 16384);

    for (int it = bx; it < 96; it += G) mod_item(c, ada_w, ada_b, mod, it, (LAS float*)lds, tid);
    {
        constexpr int I_A = (D / 64) * (N1 / 32), I_O = (W / 64) * (D / 32);
        for (int it = gw; it < I_A + 2 * I_O; it += NGW) {
            int r = it;
            if (r < I_A) { transpose_item(hg_w_in, D, N1, WA, scr, r, lane); continue; } r -= I_A;
            if (r < I_O) { transpose_item(hg_w_out, W, D, WO0, scr, r, lane); continue; } r -= I_O;
            transpose_item(sw_w_out, W, D, WO1, scr, r, lane);
        }
    }
    grid.sync();
    hmod_rows(x, mod, H, gw, NGW, lane);
    grid.sync();
    { pg8::Gemm g{H, WA, M, N1, D}; pg8::StaticOrder S; S.init(M, N1, G, bx); EpiL0 E{Qb, Fb, Vb, SZ, lbl};
      pg8::gemm_phase<EpiL0, pg8::StaticOrder, true, true>(lds, g, S, E); }
    grid.sync();
    {
        constexpr int I_B = (D / 64) * (N3 / 32);
        if (G >= 256) {
            if (bx < 128) { recur_item(bx, Qb, Fb, Vb, SZ, hg_nw, Qb, lds, tid); }
            else { for (int it = (bx - 128) * NWAVES + wave; it < I_B; it += (G - 128) * NWAVES) transpose_item(sw_w_in, D, N3, WA, scr, it, lane); }
        } else {
            for (int it = gw; it < I_B; it += NGW) transpose_item(sw_w_in, D, N3, WA, scr, it, lane);
            __syncthreads();
            for (int bh = bx; bh < 128; bh += G) recur_item(bh, Qb, Fb, Vb, SZ, hg_nw, Qb, lds, tid);
        }
    }
    grid.sync();
    { pg8::Gemm g{Qb, WO0, M, D, W}; pg8::StaticOrder S; S.init(M, D, G, bx); EpiRes E{x, mod + 2048, U0};
      pg8::gemm_phase<EpiRes, pg8::StaticOrder, false, true>(lds, g, S, E); }
    grid.sync();
    ln_rows(U0, ln_g, ln_b, X1, mod + 8 * 3072, H, gw, NGW, lane);
    grid.sync();
    { pg8::Gemm g{H, WA, M, N3, D}; pg8::StaticOrder S; S.init(M, N3, G, bx); EpiL1 E{Qb, K1, V1, SZ};
      pg8::gemm_phase<EpiL1, pg8::StaticOrder, true, true>(lds, g, S, E); }
    grid.sync();
    for (int it = bx; it < BATCH * 4 * 16; it += G) attn_item(it, Qb, K1, V1, SZ, sinks, Qb, lds, tid);
    grid.sync();
    { pg8::Gemm g{Qb, WO1, M, D, W}; pg8::StaticOrder S; S.init(M, D, G, bx); EpiRes E{X1, mod + 8 * 3072 + 2048, a.out};
      pg8::gemm_phase<EpiRes, pg8::StaticOrder, false, true>(lds, g, S, E); }
    grid.sync();
    ln_rows(a.out, ln_g + D, ln_b + D, a.out, nullptr, nullptr, gw, NGW, lane);
}

extern "C" void kernel_launch(void* const* d_in, const int* in_sizes, int n_in, void* d_out, int out_size, void* d_ws, size_t ws_size, hipStream_t stream) {
    static int grid = 0;
    if (grid == 0) {
        int dev = 0, cus = 0, per_cu = 0;
        if (hipGetDevice(&dev) != hipSuccess || hipDeviceGetAttribute(&cus, hipDeviceAttributeMultiprocessorCount, dev) != hipSuccess) { fprintf(stderr, "kernel_launch: device query failed\n"); grid = -1; return; }
        if (hipFuncSetAttribute((const void*)fwd_megakernel, hipFuncAttributeMaxDynamicSharedMemorySize, LDS_BYTES) != hipSuccess) { fprintf(stderr, "kernel_launch: hipFuncSetAttribute failed\n"); grid = -1; return; }
        if (hipOccupancyMaxActiveBlocksPerMultiprocessor(&per_cu, (const void*)fwd_megakernel, NTHR, LDS_BYTES) != hipSuccess || per_cu < 1) { fprintf(stderr, "kernel_launch: occupancy query gave %d\n", per_cu); per_cu = 1; }
        (void)hipGetLastError();
        grid = cus * per_cu;
        fprintf(stderr, "kernel_launch: grid %d (cus %d x %d), ws %zu\n", grid, cus, per_cu, ws_size);
    }
    if (grid < 0) return;
    Args a{};
    for (int i = 0; i < 13; ++i) a.in[i] = (const float*)d_in[i];
    a.out = (float*)d_out; a.ws = (unsigned char*)d_ws;
    void* args[] = {&a};
    hipError_t e = hipLaunchCooperativeKernel((const void*)fwd_megakernel, dim3(grid), dim3(NTHR), args, LDS_BYTES, stream);
    if (e != hipSuccess) fprintf(stderr, "kernel_launch: cooperative launch failed: %s (grid %d)\n", hipGetErrorString(e), grid);
}
```

```cpp
#include <hip/hip_runtime.h>
#include <hip/hip_cooperative_groups.h>
#include <cstdio>
#include <cstdint>
namespace cg = cooperative_groups;
namespace pg8 {
#define PG8_LAS __attribute__((address_space(3)))
typedef unsigned short bf16_t;
typedef short bf16x8 __attribute__((ext_vector_type(8)));
typedef float f32x4 __attribute__((ext_vector_type(4)));
typedef unsigned u32x4 __attribute__((ext_vector_type(4)));
constexpr int BM = 256, BK = 64, HALF = 128, HTB = HALF * BK * 2  , STAGE_BYTES = 8 * HTB, NXCD = 8, WGM = 8;

__host__ __device__ __forceinline__ int lds_byte(int r, int c) { const int st = (r >> 4) * 2 + (c >> 5), rr = r & 15, cc = c & 31, ob = rr * 64 + cc * 2; return st * 1024 + (ob ^ (((ob >> 9) & 1) << 5)); }
__host__ __device__ __forceinline__ void stage_rc(int b, int& R, int& C) { const int st = b / 1024, sb = b % 1024, swz = sb ^ (((sb >> 9) & 1) << 5); R = (st >> 1) * 16 + swz / 64; C = (st & 1) * 32 + (swz % 64) / 2; }
__host__ __device__ __forceinline__ int perm32(int rho) { const int n = rho >> 4, i = rho & 15; return 8 * (i >> 2) + 4 * n + (i & 3); }

struct Unit { int pm, pn; };
struct Gemm { const bf16_t* A; const bf16_t* Bt; int M, N, K; };

struct StaticOrder {
    int nM, nN, nwg, G, c;
    __host__ __device__ void init(int M, int N, int G_, int c_) { nM = M / BM; nN = N / BM; nwg = nM * nN; G = G_; c = c_; }
    __host__ __device__ bool next(int i, Unit& u) const {
        const long L = (long)i * G + c; if (L >= nwg) return false;
        int wgid = (int)L; { const int q = nwg / NXCD, r = nwg % NXCD, xcd = wgid % NXCD, off = wgid / NXCD; wgid = (xcd < r ? xcd * (q + 1) : r * (q + 1) + (xcd - r) * q) + off; }
        const int nig = WGM * nN, gid = wgid / nig, fm = gid * WGM, gsz = (nM - fm) < WGM ? (nM - fm) : WGM;
        u.pm = fm + ((wgid % nig) % gsz); u.pn = (wgid % nig) / gsz; return true;
    }
    __device__ __forceinline__ void a_ready(const Unit&) const {}
    __device__ __forceinline__ void done(const Unit&) const {}
};

__device__ __forceinline__ unsigned cvt_pk_bf16(float lo, float hi) { unsigned r; asm volatile("v_cvt_pk_bf16_f32 %0, %1, %2" : "=v"(r) : "v"(lo), "v"(hi)); return r; }
typedef float f32x2 __attribute__((ext_vector_type(2)));
template <class Epi, class Sched, bool ALIGN_EPI = false, bool SP2 = false>
__device__ __forceinline__ void gemm_phase(PG8_LAS unsigned char* lds, const Gemm g, const Sched& S, const Epi& E) {
    const int tid = threadIdx.x, wid = __builtin_amdgcn_readfirstlane(tid >> 6), lane = tid & 63, wr = wid >> 2, wc = wid & 3, fr = lane & 15, fq = lane >> 4;
    const int K = g.K, nt = K / BK;
    unsigned voffA[2], voffB[2];
#pragma unroll
    for (int i = 0; i < 2; ++i) { int R, C; stage_rc(tid * 16 + i * 8192, R, C); const int Rb = Epi::PERM ? ((R & ~31) + perm32(R & 31)) : R;
        voffA[i] = (unsigned)(R * K + C) * 2u; voffB[i] = (unsigned)(Rb * K + C) * 2u; }
    const size_t kstep = (size_t)(BK * 2);
    const size_t hstep = (size_t)HALF * K * 2;
    const size_t tstep = 2 * hstep;
    const unsigned ldsw = (unsigned)wid * 1024u;
    const int aoff = lds_byte(wr * 64 + fr, fq * 8), boff = lds_byte(wc * 32 + fr, fq * 8);
#define PG8_SA(b, h) (((b) * 2 + (h)) * HTB)
#define PG8_SB(b, h) ((4 + (b) * 2 + (h)) * HTB)
#define PG8_STAGE(bufoff, gbase, voff) do { _Pragma("unroll") for (int _i = 0; _i < 2; ++_i) \
        __builtin_amdgcn_global_load_lds((const unsigned*)((const char*)(gbase) + (voff)[_i]), (PG8_LAS unsigned*)(lds + (bufoff) + ldsw + _i * 8192), 16, 0, 0); } while (0)
#define PG8_LDA(dst, b, h) do { _Pragma("unroll") for (int m = 0; m < 4; ++m) _Pragma("unroll") for (int k = 0; k < 2; ++k) dst[m][k] = *(const PG8_LAS bf16x8*)(lds + PG8_SA(b, h) + aoff + m * 2048 + k * 1024); } while (0)
#define PG8_LDB(dst, b, h) do { _Pragma("unroll") for (int n = 0; n < 2; ++n) _Pragma("unroll") for (int k = 0; k < 2; ++k) dst[n][k] = *(const PG8_LAS bf16x8*)(lds + PG8_SB(b, h) + boff + n * 2048 + k * 1024); } while (0)
#define PG8_MMA(ai, bj, At, Bt) do { __builtin_amdgcn_s_setprio(1); _Pragma("unroll") for (int m = 0; m < 4; ++m) _Pragma("unroll") for (int n = 0; n < 2; ++n) _Pragma("unroll") for (int k = 0; k < 2; ++k) \
        acc[ai][bj][m][n] = __builtin_amdgcn_mfma_f32_16x16x32_bf16(Bt[n][k], At[m][k], acc[ai][bj][m][n], 0, 0, 0); __builtin_amdgcn_s_setprio(0); } while (0)
#define PG8_WAIT_V(n) asm volatile("s_waitcnt vmcnt(" #n ")" ::: "memory")
#define PG8_WAIT_L(n) asm volatile("s_waitcnt lgkmcnt(" #n ")" ::: "memory")
#define PG8_BAR __builtin_amdgcn_s_barrier()
#define PG8_SCHED __builtin_amdgcn_sched_barrier(0)
    Unit cur, nxt; int ui = 0;
    if (!S.next(0, cur)) return;
    f32x4 acc[2][2][4][2];
#pragma unroll
    for (int a = 0; a < 2; ++a)
#pragma unroll
        for (int b = 0; b < 2; ++b)
#pragma unroll
            for (int m = 0; m < 4; ++m)
#pragma unroll
                for (int n = 0; n < 2; ++n) acc[a][b][m][n] = (f32x4){0.f, 0.f, 0.f, 0.f};
    bf16x8 At[4][2], B0[2][2], B1[2][2];
    const char* cA = (const char*)g.A + (size_t)cur.pm * tstep; const char* cB = (const char*)g.Bt + (size_t)cur.pn * tstep;
    S.a_ready(cur);
    if constexpr (SP2) {
        PG8_STAGE(PG8_SB(0, 0), cB, voffB); PG8_STAGE(PG8_SB(0, 1), cB + hstep, voffB); PG8_STAGE(PG8_SA(0, 0), cA, voffA); PG8_STAGE(PG8_SA(0, 1), cA + hstep, voffA);
        if (wr == 1) PG8_BAR;
        PG8_WAIT_V(2); PG8_BAR;
        PG8_STAGE(PG8_SB(1, 0), cB + kstep, voffB); PG8_STAGE(PG8_SA(1, 0), cA + kstep, voffA); PG8_STAGE(PG8_SB(1, 1), cB + hstep + kstep, voffB);
        PG8_WAIT_V(6); PG8_BAR;
    } else {
        PG8_STAGE(PG8_SB(0, 0), cB, voffB); PG8_STAGE(PG8_SA(0, 0), cA, voffA); PG8_STAGE(PG8_SB(0, 1), cB + hstep, voffB); PG8_STAGE(PG8_SA(0, 1), cA + hstep, voffA);
        if (wr == 1) PG8_BAR;
        PG8_WAIT_V(4); PG8_BAR;
        PG8_STAGE(PG8_SB(1, 0), cB + kstep, voffB); PG8_STAGE(PG8_SA(1, 0), cA + kstep, voffA); PG8_STAGE(PG8_SB(1, 1), cB + hstep + kstep, voffB);
        PG8_WAIT_V(6); PG8_BAR;
    }
    for (;;) {
        const bool has_next = S.next(ui + 1, nxt);
        const char* nA = has_next ? (const char*)g.A + (size_t)nxt.pm * tstep : cA; const char* nB = has_next ? (const char*)g.Bt + (size_t)nxt.pn * tstep : cB;
        for (int t = 0; t < nt; t += 2) {
            const bool last = (t == nt - 2);
            const char* a1 = cA + (size_t)(t + 1) * kstep;
            const char* a2 = last ? nA : cA + (size_t)(t + 2) * kstep; const char* b2 = last ? nB : cB + (size_t)(t + 2) * kstep;
            const char* a3 = a2 + kstep; const char* b3 = b2 + kstep;
            if (last && has_next) S.a_ready(nxt);
            if constexpr (SP2) {
            PG8_LDB(B0, 0, 0); PG8_LDB(B1, 0, 1); PG8_SCHED; PG8_LDA(At, 0, 0); PG8_STAGE(PG8_SA(1, 1), a1 + hstep, voffA);
            PG8_WAIT_V(8); PG8_WAIT_L(0); PG8_BAR; PG8_MMA(0, 0, At, B0); PG8_MMA(0, 1, At, B1); PG8_BAR; PG8_SCHED;
            PG8_LDA(At, 0, 1); PG8_STAGE(PG8_SB(0, 0), b2, voffB); PG8_STAGE(PG8_SB(0, 1), b2 + hstep, voffB); PG8_STAGE(PG8_SA(0, 0), a2, voffA);
            PG8_WAIT_V(8); PG8_WAIT_L(0); PG8_BAR; PG8_MMA(1, 0, At, B0); PG8_MMA(1, 1, At, B1); PG8_BAR; PG8_SCHED;
            PG8_LDB(B0, 1, 0); PG8_LDB(B1, 1, 1); PG8_SCHED; PG8_LDA(At, 1, 0); PG8_STAGE(PG8_SA(0, 1), a2 + hstep, voffA);
            PG8_WAIT_V(8); PG8_WAIT_L(0); PG8_BAR; PG8_MMA(0, 0, At, B0); PG8_MMA(0, 1, At, B1); PG8_BAR; PG8_SCHED;
            PG8_LDA(At, 1, 1); PG8_STAGE(PG8_SB(1, 0), b3, voffB); PG8_STAGE(PG8_SB(1, 1), b3 + hstep, voffB); PG8_STAGE(PG8_SA(1, 0), a3, voffA);
            PG8_WAIT_V(8); PG8_WAIT_L(0); PG8_BAR; PG8_MMA(1, 0, At, B0); PG8_MMA(1, 1, At, B1); PG8_BAR; PG8_SCHED;
            } else {
            PG8_LDB(B0, 0, 0); PG8_SCHED; PG8_LDA(At, 0, 0); PG8_STAGE(PG8_SA(1, 1), a1 + hstep, voffA);
            PG8_WAIT_L(8); PG8_BAR; PG8_WAIT_L(0); PG8_MMA(0, 0, At, B0); PG8_BAR; PG8_SCHED;
            PG8_LDB(B1, 0, 1); PG8_STAGE(PG8_SB(0, 0), b2, voffB);
            PG8_BAR; PG8_WAIT_L(0); PG8_MMA(0, 1, At, B1); PG8_BAR;
            PG8_LDA(At, 0, 1); PG8_STAGE(PG8_SA(0, 0), a2, voffA);
            PG8_BAR; PG8_WAIT_L(0); PG8_MMA(1, 0, At, B0); PG8_BAR; PG8_SCHED;
            PG8_STAGE(PG8_SB(0, 1), b2 + hstep, voffB);
            PG8_WAIT_V(6); PG8_BAR; PG8_MMA(1, 1, At, B1); PG8_BAR;
            PG8_LDB(B0, 1, 0); PG8_SCHED; PG8_LDA(At, 1, 0); PG8_STAGE(PG8_SA(0, 1), a2 + hstep, voffA);
            PG8_WAIT_L(8); PG8_BAR; PG8_WAIT_L(0); PG8_MMA(0, 0, At, B0); PG8_BAR; PG8_SCHED;
            PG8_LDB(B1, 1, 1); PG8_STAGE(PG8_SB(1, 0), b3, voffB);
            PG8_BAR; PG8_WAIT_L(0); PG8_MMA(0, 1, At, B1); PG8_BAR;
            PG8_LDA(At, 1, 1); PG8_STAGE(PG8_SA(1, 0), a3, voffA);
            PG8_BAR; PG8_WAIT_L(0); PG8_MMA(1, 0, At, B0); PG8_BAR; PG8_SCHED;
            PG8_STAGE(PG8_SB(1, 1), b3 + hstep, voffB);
            PG8_WAIT_V(6); PG8_BAR; PG8_MMA(1, 1, At, B1); PG8_BAR;
            }
        }
        if constexpr (ALIGN_EPI) { if (wr == 0) PG8_BAR; }
        if constexpr (!Epi::AFTER_DRAIN) { E(acc, cur, wr, wc, fr, fq); S.done(cur); }
        if (!has_next) break;
#pragma unroll
        for (int a = 0; a < 2; ++a)
#pragma unroll
            for (int b = 0; b < 2; ++b)
#pragma unroll
                for (int m = 0; m < 4; ++m)
#pragma unroll
                    for (int n = 0; n < 2; ++n) acc[a][b][m][n] = (f32x4){0.f, 0.f, 0.f, 0.f};
        cur = nxt; cA = nA; cB = nB; ++ui;
        if constexpr (ALIGN_EPI) { if (wr == 1) PG8_BAR; }
    }
    PG8_WAIT_V(0);
    if constexpr (!ALIGN_EPI) { if (wr == 0) PG8_BAR; }
    PG8_BAR;
    if constexpr (Epi::AFTER_DRAIN) { E.fused(acc, cur, wr, wc, fr, fq, lds, wid, lane); S.done(cur); }
#undef PG8_SA
#undef PG8_SB
#undef PG8_STAGE
#undef PG8_LDA
#undef PG8_LDB
#undef PG8_MMA
#undef PG8_WAIT_V
#undef PG8_WAIT_L
#undef PG8_BAR
#undef PG8_SCHED
}
}

#define LAS __attribute__((address_space(3)))
typedef unsigned short bf16;
typedef unsigned v4u __attribute__((ext_vector_type(4)));
typedef unsigned v2u __attribute__((ext_vector_type(2)));
typedef float f32x4 __attribute__((ext_vector_type(4)));
typedef float f32x16 __attribute__((ext_vector_type(16)));
typedef short bf16x8 __attribute__((ext_vector_type(8)));
typedef float f32x2_t __attribute__((ext_vector_type(2)));
typedef __bf16 bf16x2_t __attribute__((ext_vector_type(2)));
typedef _Float16 h16x2_t __attribute__((ext_vector_type(2)));
__device__ __forceinline__ unsigned pk2(float lo, float hi) { f32x2_t v = {lo, hi}; bf16x2_t b = __builtin_convertvector(v, bf16x2_t); return __builtin_bit_cast(unsigned, b); }
__device__ __forceinline__ unsigned pkh2(float lo, float hi) { h16x2_t h = {(_Float16)lo, (_Float16)hi}; return __builtin_bit_cast(unsigned, h); }
__device__ __forceinline__ float bf2f(unsigned short u) { return __uint_as_float((unsigned)u << 16); }
__device__ __forceinline__ float bflo(unsigned u) { return __uint_as_float(u << 16); }
__device__ __forceinline__ float bfhi(unsigned u) { return __uint_as_float(u & 0xffff0000u); }
__device__ __forceinline__ float sigmoidf_(float x) { return __builtin_amdgcn_rcpf(1.0f + __expf(-x)); }
__device__ __forceinline__ bf16x8 pack8(f32x4 a, f32x4 b) { v4u w; w.x = pk2(a[0], a[1]); w.y = pk2(a[2], a[3]); w.z = pk2(b[0], b[1]); w.w = pk2(b[2], b[3]); return __builtin_bit_cast(bf16x8, w); }
#define MFMA16(a, b, c) __builtin_amdgcn_mfma_f32_16x16x32_bf16((a), (b), (c), 0, 0, 0)
#define MFMA32(a, b, c) __builtin_amdgcn_mfma_f32_32x32x16_bf16((a), (b), (c), 0, 0, 0)
#define LDS_WAIT() asm volatile("s_waitcnt lgkmcnt(0)" ::: "memory")

constexpr int BATCH = 8, T = 2048, D = 1024, W = 2048, M = BATCH * T;
constexpr int N1 = 4 * W;
constexpr int KVW = 256, N3 = W + 2 * KVW + W;
constexpr float ALPHA = 1.41421356237309515f;
constexpr float LOG2E = 1.4426950408889634f;
constexpr float QSCALE = 0.125f * LOG2E;
constexpr int NWAVES = 8, NTHR = 512;
constexpr int LDS_BYTES = 147456;

constexpr size_t MiB = 1u << 20;
constexpr size_t WS_BAR = 512 * 1024;
constexpr size_t WS_MOD = 4096;
constexpr size_t WS_WA = 1 * MiB;
constexpr size_t WS_WO0 = 17 * MiB;
constexpr size_t WS_H = 21 * MiB;
constexpr size_t WS_Q = 53 * MiB;
constexpr size_t WS_F = 117 * MiB;
constexpr size_t WS_V = 181 * MiB;
constexpr size_t WS_WO1 = 245 * MiB;

__device__ __forceinline__ void transpose_item(const float* Wm, int K, int N, bf16* WT, LAS float* scr, int item, int lane) {
    const int nblk = N / 32, kb = item / nblk, nb = item % nblk, k0 = 64 * kb, n0 = 32 * nb;
#pragma unroll 8
    for (int i = 0; i < 32; ++i) { const int kk = 2 * i + (lane >> 5); scr[kk * 33 + (lane & 31)] = Wm[(size_t)(k0 + kk) * N + n0 + (lane & 31)]; }
    LDS_WAIT();
    const int c = lane & 7;
#pragma unroll
    for (int j = 0; j < 4; ++j) { const int n = (lane >> 3) + 8 * j; const LAS float* s = scr + (8 * c) * 33 + n;
        v4u o; o.x = pk2(s[0 * 33], s[1 * 33]); o.y = pk2(s[2 * 33], s[3 * 33]); o.z = pk2(s[4 * 33], s[5 * 33]); o.w = pk2(s[6 * 33], s[7 * 33]);
        *(v4u*)(WT + (size_t)(n0 + n) * K + k0 + 8 * c) = o; }
    LDS_WAIT();
}

__device__ __forceinline__ float wave_sum(float v) {
#pragma unroll
    for (int o = 1; o < 64; o <<= 1) v += __shfl_xor(v, o);
    return v;
}

__device__ __forceinline__ void mod_item(const float* c, const float* ada_w, const float* ada_b, float* mod, int item, LAS float* red, int tid) {
    const int l = item / 48, eb = item % 48, wave = tid >> 6, lane = tid & 63, e = eb * 64 + lane;
    float sc0[8], sc1[8], acc[8];
#pragma unroll
    for (int b = 0; b < 8; ++b) { float v = c[b * 1024 + 128 * wave + lane]; sc0[b] = v * sigmoidf_(v); v = c[b * 1024 + 128 * wave + 64 + lane]; sc1[b] = v * sigmoidf_(v); acc[b] = 0.f; }
    const float* wp = ada_w + (size_t)l * 1024 * 3072 + (size_t)(128 * wave) * 3072 + e;
#pragma unroll 8
    for (int dd = 0; dd < 64; ++dd) { const float wv = wp[(size_t)dd * 3072];
#pragma unroll
        for (int b = 0; b < 8; ++b) acc[b] += __shfl(sc0[b], dd) * wv; }
    wp += (size_t)64 * 3072;
#pragma unroll 8
    for (int dd = 0; dd < 64; ++dd) { const float wv = wp[(size_t)dd * 3072];
#pragma unroll
        for (int b = 0; b < 8; ++b) acc[b] += __shfl(sc1[b], dd) * wv; }
#pragma unroll
    for (int b = 0; b < 8; ++b) red[(wave * 8 + b) * 64 + lane] = acc[b];
    __syncthreads();
    { const int b = tid >> 6; float s = 0.f;
#pragma unroll
      for (int w = 0; w < 8; ++w) s += red[(w * 8 + b) * 64 + lane];
      mod[(l * 8 + b) * 3072 + e] = s + ada_b[l * 3072 + e]; }
    __syncthreads();
}

__device__ __forceinline__ void hmod_rows(const float* x, const float* modl, bf16* H, int gw, int NGW, int lane) {
    for (int m = gw; m < M; m += NGW) {
        const int b = m >> 11;
        const f32x4* xr = (const f32x4*)(x + (size_t)m * D) + lane;
        const f32x4* sh = (const f32x4*)(modl + b * 3072) + lane;
        const f32x4* sc = (const f32x4*)(modl + b * 3072 + 1024) + lane;
        v2u* o = (v2u*)(H + (size_t)m * D) + lane;
#pragma unroll
        for (int j = 0; j < 4; ++j) { const f32x4 v = xr[64 * j], s = sc[64 * j], t = sh[64 * j]; const f32x4 h = v * (1.0f + s) + t;
            v2u w; w.x = pk2(h[0], h[1]); w.y = pk2(h[2], h[3]); o[64 * j] = w; }
    }
}

__device__ __forceinline__ void ln_rows(const float* u, const float* g, const float* bt, float* xo, const float* modl, bf16* H, int gw, int NGW, int lane) {
    f32x4 gv[4], bv[4];
#pragma unroll
    for (int j = 0; j < 4; ++j) { gv[j] = ((const f32x4*)g)[64 * j + lane]; bv[j] = ((const f32x4*)bt)[64 * j + lane]; }
    for (int m = gw; m < M; m += NGW) {
        const f32x4* ur = (const f32x4*)(u + (size_t)m * D) + lane;
        f32x4 v[4]; float s = 0.f;
#pragma unroll
        for (int j = 0; j < 4; ++j) { v[j] = ur[64 * j]; s += (v[j][0] + v[j][1]) + (v[j][2] + v[j][3]); }
        const float mean = wave_sum(s) * (1.0f / D); float s2 = 0.f;
#pragma unroll
        for (int j = 0; j < 4; ++j) { v[j] = v[j] - mean; s2 += (v[j][0] * v[j][0] + v[j][1] * v[j][1]) + (v[j][2] * v[j][2] + v[j][3] * v[j][3]); }
        const float rstd = 1.0f / sqrtf(wave_sum(s2) * (1.0f / D) + 1e-5f);
        f32x4* xr = (f32x4*)(xo + (size_t)m * D) + lane;
#pragma unroll
        for (int j = 0; j < 4; ++j) { v[j] = v[j] * rstd * gv[j] + bv[j]; xr[64 * j] = v[j]; }
        if (H) {
            const int b = m >> 11;
            const f32x4* sh = (const f32x4*)(modl + b * 3072) + lane;
            const f32x4* sc = (const f32x4*)(modl + b * 3072 + 1024) + lane;
            v2u* o = (v2u*)(H + (size_t)m * D) + lane;
#pragma unroll
            for (int j = 0; j < 4; ++j) { const f32x4 h = v[j] * (1.0f + sc[64 * j]) + sh[64 * j]; v2u w; w.x = pk2(h[0], h[1]); w.y = pk2(h[2], h[3]); o[64 * j] = w; }
        }
    }
}

typedef pg8::f32x4 pf4;
struct EpiL0 {
    static constexpr bool PERM = true, AFTER_DRAIN = false;
    bf16* Q; bf16* F; bf16* V; bf16* SZ; const float* lbl;
    __device__ __forceinline__ void operator()(const pf4 (&acc)[2][2][4][2], const pg8::Unit& u, int wr, int wc, int fr, int fq) const {
        const int type = u.pn >> 3, colt = (u.pn & 7) * 256;
        const int row0 = u.pm * 256 + wr * 64 + fr, col0 = colt + wc * 32 + 8 * fq;
        bf16* base = type == 0 ? Q : (type == 1 ? F : (type == 2 ? V : SZ));
        float lb[2][8];
#pragma unroll
        for (int bj = 0; bj < 2; ++bj)
#pragma unroll
            for (int e = 0; e < 8; ++e) lb[bj][e] = 0.f;
        if (type == 1) {
#pragma unroll
            for (int bj = 0; bj < 2; ++bj)
#pragma unroll
                for (int e = 0; e < 8; ++e) { const int c = col0 + bj * 128 + e; lb[bj][e] = __builtin_amdgcn_rcpf(1.0f + __expf(lbl[2048 + c] - lbl[c])); }
        }
#pragma unroll
        for (int ai = 0; ai < 2; ++ai)
#pragma unroll
            for (int m = 0; m < 4; ++m) { bf16* rowp = base + (size_t)(row0 + ai * 128 + m * 16) * 2048 + col0;
#pragma unroll
                for (int bj = 0; bj < 2; ++bj) { float v[8];
#pragma unroll
                    for (int e = 0; e < 4; ++e) { v[e] = acc[ai][bj][m][0][e]; v[4 + e] = acc[ai][bj][m][1][e]; }
                    v4u w;
                    if (type == 1) {
#pragma unroll
                        for (int e = 0; e < 8; ++e) v[e] = lb[bj][e] + (1.0f - lb[bj][e]) * sigmoidf_(v[e]);
                        w.x = pkh2(v[0], v[1]); w.y = pkh2(v[2], v[3]); w.z = pkh2(v[4], v[5]); w.w = pkh2(v[6], v[7]);
                    } else {
                        if (type == 3) {
#pragma unroll
                            for (int e = 0; e < 8; ++e) v[e] = v[e] * sigmoidf_(v[e]);
                        }
                        w.x = pk2(v[0], v[1]); w.y = pk2(v[2], v[3]); w.z = pk2(v[4], v[5]); w.w = pk2(v[6], v[7]);
                    }
                    *(v4u*)(rowp + bj * 128) = w; } }
    }
};
struct EpiL1 {
    static constexpr bool PERM = true, AFTER_DRAIN = false;
    bf16* Q; bf16* K; bf16* V; bf16* SZ;
    __device__ __forceinline__ void operator()(const pf4 (&acc)[2][2][4][2], const pg8::Unit& u, int wr, int wc, int fr, int fq) const {
        const int pn = u.pn;
        bf16* base; int ldc, colt; float sc = 1.0f; bool act = false;
        if (pn < 8) { base = Q; ldc = 2048; colt = pn * 256; sc = QSCALE; }
        else if (pn == 8) { base = K; ldc = 256; colt = 0; }
        else if (pn == 9) { base = V; ldc = 256; colt = 0; }
        else { base = SZ; ldc = 2048; colt = (pn - 10) * 256; act = true; }
        const int row0 = u.pm * 256 + wr * 64 + fr, col0 = colt + wc * 32 + 8 * fq;
#pragma unroll
        for (int ai = 0; ai < 2; ++ai)
#pragma unroll
            for (int m = 0; m < 4; ++m) { bf16* rowp = base + (size_t)(row0 + ai * 128 + m * 16) * ldc + col0;
#pragma unroll
                for (int bj = 0; bj < 2; ++bj) { float v[8];
#pragma unroll
                    for (int e = 0; e < 4; ++e) { v[e] = acc[ai][bj][m][0][e] * sc; v[4 + e] = acc[ai][bj][m][1][e] * sc; }
                    if (act) {
#pragma unroll
                        for (int e = 0; e < 8; ++e) v[e] = v[e] * sigmoidf_(v[e]);
                    }
                    v4u w; w.x = pk2(v[0], v[1]); w.y = pk2(v[2], v[3]); w.z = pk2(v[4], v[5]); w.w = pk2(v[6], v[7]);
                    *(v4u*)(rowp + bj * 128) = w; } }
    }
};
struct EpiRes {
    static constexpr bool PERM = false, AFTER_DRAIN = false;
    const float* xin; const float* gate; float* out;
    __device__ __forceinline__ void operator()(const pf4 (&acc)[2][2][4][2], const pg8::Unit& u, int wr, int wc, int fr, int fq) const {
        const int row0 = u.pm * 256 + wr * 64 + fr, col0 = u.pn * 256 + wc * 32 + 4 * fq, b = (u.pm * 256) >> 11;
        pf4 gt[2][2];
#pragma unroll
        for (int bj = 0; bj < 2; ++bj)
#pragma unroll
            for (int n = 0; n < 2; ++n) gt[bj][n] = *(const pf4*)(gate + b * 3072 + col0 + bj * 128 + n * 16) + 1.0f;
#pragma unroll
        for (int ai = 0; ai < 2; ++ai)
#pragma unroll
            for (int m = 0; m < 4; ++m) { const size_t off = (size_t)(row0 + ai * 128 + m * 16) * D + col0;
#pragma unroll
                for (int bj = 0; bj < 2; ++bj)
#pragma unroll
                    for (int n = 0; n < 2; ++n) { const pf4 xv = *(const pf4*)(xin + off + bj * 128 + n * 16);
                        *(pf4*)(out + off + bj * 128 + n * 16) = xv * ALPHA + gt[bj][n] * acc[ai][bj][m][n]; } }
    }
};

constexpr int RC_IN = 34816, RC_QT = 0, RC_KT = 8704, RC_KTT = 17408, RC_VT = 25600, RC_PL = 33792;
constexpr int RC_OUT0 = 2 * RC_IN, RC_OUT = 17408, RC_SSQ = 16896;
#define RC_BAR() do { asm volatile("s_waitcnt lgkmcnt(0)" ::: "memory"); __builtin_amdgcn_s_barrier(); asm volatile("" ::: "memory"); } while (0)
struct PSet { v4u f0, f1, q0, q1, v0, v1, z0, z1; };
__device__ __forceinline__ float dpp_mul_step(float v, float src_shifted) { return v * src_shifted; }
#define DPPF(v, ctrl, rmask) __builtin_bit_cast(float, __builtin_amdgcn_update_dpp(0x3f800000, __builtin_bit_cast(int, (v)), (ctrl), (rmask), 0xf, false))
__device__ __forceinline__ float scan32_mul(float v) {
    v *= DPPF(v, 0x111, 0xf); v *= DPPF(v, 0x112, 0xf); v *= DPPF(v, 0x114, 0xf); v *= DPPF(v, 0x118, 0xf); v *= DPPF(v, 0x142, 0xa);
    return v;
}
__device__ __forceinline__ float h2f_lo(unsigned u) { return (float)__builtin_bit_cast(_Float16, (unsigned short)(u & 0xffffu)); }
__device__ __forceinline__ float h2f_hi(unsigned u) { return (float)__builtin_bit_cast(_Float16, (unsigned short)(u >> 16)); }
__device__ __forceinline__ void rc_load(PSet& s, const bf16* Q, const bf16* Fh, const bf16* V, size_t base) {
    s.f0 = *(const v4u*)(Fh + base); s.f1 = *(const v4u*)(Fh + base + 64);
    s.q0 = *(const v4u*)(Q + base);  s.q1 = *(const v4u*)(Q + base + 64);
    s.v0 = *(const v4u*)(V + base);  s.v1 = *(const v4u*)(V + base + 64);
}
__device__ __forceinline__ void rc_produce_half(const v4u fw, const v4u qw, const v4u vw, LAS unsigned char* in, int t, int k0) {
    float f[8], P[8];
#pragma unroll
    for (int e = 0; e < 4; ++e) { f[2 * e] = h2f_lo(fw[e]); f[2 * e + 1] = h2f_hi(fw[e]); }
#pragma unroll
    for (int e = 0; e < 8; ++e) P[e] = scan32_mul(f[e]);
    v4u qo, ko;
#pragma unroll
    for (int e = 0; e < 4; ++e) {
        qo[e] = pk2(bflo(qw[e]) * P[2 * e], bfhi(qw[e]) * P[2 * e + 1]);
        ko[e] = pk2((1.0f - f[2 * e]) * __builtin_amdgcn_rcpf(P[2 * e]), (1.0f - f[2 * e + 1]) * __builtin_amdgcn_rcpf(P[2 * e + 1]));
    }
    *(LAS v4u*)(in + RC_QT + t * 272 + k0 * 2) = qo;
    *(LAS v4u*)(in + RC_KT + t * 272 + k0 * 2) = ko;
#pragma unroll
    for (int e = 0; e < 8; ++e) {
        const unsigned kwv = ko[e >> 1], vwv = vw[e >> 1];
        *(LAS unsigned short*)(in + RC_KTT + (k0 + e) * 64 + t * 2) = (unsigned short)((e & 1) ? (kwv >> 16) : (kwv & 0xffffu));
        *(LAS unsigned short*)(in + RC_VT + (k0 + e) * 64 + t * 2) = (unsigned short)((e & 1) ? (vwv >> 16) : (vwv & 0xffffu));
    }
    if (t == 31) {
        *(LAS f32x4*)(in + RC_PL + k0 * 4) = (f32x4){P[0], P[1], P[2], P[3]};
        *(LAS f32x4*)(in + RC_PL + k0 * 4 + 16) = (f32x4){P[4], P[5], P[6], P[7]};
    }
}
__device__ __forceinline__ void rc_finalize_half(const v4u zw, const float* nw8, float rs, const LAS unsigned char* ob, int t, int c0, bf16* dst) {
    const f32x4 a0 = *(const LAS f32x4*)(ob + (t * 132 + c0) * 4), a1 = *(const LAS f32x4*)(ob + (t * 132 + c0) * 4 + 16);
    v4u w;
    w.x = pk2(a0[0] * rs * nw8[0] * bflo(zw.x), a0[1] * rs * nw8[1] * bfhi(zw.x));
    w.y = pk2(a0[2] * rs * nw8[2] * bflo(zw.y), a0[3] * rs * nw8[3] * bfhi(zw.y));
    w.z = pk2(a1[0] * rs * nw8[4] * bflo(zw.z), a1[1] * rs * nw8[5] * bfhi(zw.z));
    w.w = pk2(a1[2] * rs * nw8[6] * bflo(zw.w), a1[3] * rs * nw8[7] * bfhi(zw.w));
    *(v4u*)dst = w;
}
__device__ __forceinline__ void rc_prod_step(int n, PSet& cur, PSet& nxt, const float (&nw)[16],
                                             const bf16* Q, const bf16* Fh, const bf16* V, const bf16* SZ, bf16* OG, size_t colbase, size_t rowb, LAS unsigned char* lds, int wave, int lane, size_t omask = ~(size_t)0) {
    constexpr int NCH = T / 32;
    const int p = wave * 64 + lane, t = p & 31, oc = p >> 5;
    asm volatile("" :: "v"(cur.f0), "v"(cur.f1), "v"(cur.q0), "v"(cur.q1), "v"(cur.v0), "v"(cur.v1), "v"(cur.z0), "v"(cur.z1));
    if (n + 3 < NCH) rc_load(nxt, Q, Fh, V, (rowb + (size_t)(n + 3) * 32 + t) * W + colbase + 8 * oc);
    if (n + 1 < NCH) { const bf16* zp = SZ + (rowb + (size_t)(n + 1) * 32 + t) * W + colbase + 8 * oc; nxt.z0 = *(const v4u*)zp; nxt.z1 = *(const v4u*)(zp + 64); }
    if (n >= 1) {
        const int m = n - 1;
        const LAS unsigned char* ob = lds + RC_OUT0 + (m & 1) * RC_OUT;
        const LAS float* sq = (const LAS float*)(ob + RC_SSQ);
        const float tot = (sq[t] + sq[32 + t]) + (sq[64 + t] + sq[96 + t]);
        const float rs = __builtin_amdgcn_rsqf(tot * (1.0f / 128.0f) + 1e-6f);
        bf16* dst = OG + ((((rowb + (size_t)m * 32 + t) * W + colbase + 8 * oc)) & omask);
        rc_finalize_half(cur.z0, nw, rs, ob, t, 8 * oc, dst);
        rc_finalize_half(cur.z1, nw + 8, rs, ob, t, 64 + 8 * oc, dst + 64);
    }
    if (n + 1 < NCH) {
        LAS unsigned char* in = lds + ((n + 1) & 1) * RC_IN;
        rc_produce_half(cur.f0, cur.q0, cur.v0, in, t, 8 * oc);
        rc_produce_half(cur.f1, cur.q1, cur.v1, in, t, 64 + 8 * oc);
    }
}
__device__ __forceinline__ void rc_cons_step(int n, f32x4 (&S)[2][8], LAS unsigned char* lds, int wave, int lane) {
        const int c = wave - 4, r16 = lane & 15, quad = lane >> 4;
        const LAS unsigned char* in = lds + (n & 1) * RC_IN;
        const LAS unsigned char* qt = in + RC_QT; const LAS unsigned char* kt = in + RC_KT; const LAS unsigned char* ktT = in + RC_KTT; const LAS unsigned char* vT = in + RC_VT;
        const LAS float* plast = (const LAS float*)(in + RC_PL);
        LAS unsigned char* ob = lds + RC_OUT0 + (n & 1) * RC_OUT;
        f32x4 o[2][2];
#pragma unroll
        for (int u = 0; u < 2; ++u) { o[u][0] = (f32x4){0.f, 0.f, 0.f, 0.f}; o[u][1] = o[u][0]; }
#pragma unroll
        for (int kk = 0; kk < 4; ++kk) {
            const bf16x8 Sb0 = pack8(S[0][2 * kk], S[0][2 * kk + 1]), Sb1 = pack8(S[1][2 * kk], S[1][2 * kk + 1]);
#pragma unroll
            for (int tt = 0; tt < 2; ++tt) {
                const LAS unsigned char* ap = qt + (16 * tt + r16) * 272 + (32 * kk + 4 * quad) * 2;
                const v2u lo = *(const LAS v2u*)ap, hi = *(const LAS v2u*)(ap + 32);
                v4u aw; aw.x = lo.x; aw.y = lo.y; aw.z = hi.x; aw.w = hi.y;
                const bf16x8 A = __builtin_bit_cast(bf16x8, aw);
                o[0][tt] = MFMA16(A, Sb0, o[0][tt]); o[1][tt] = MFMA16(A, Sb1, o[1][tt]);
            }
        }
        f32x4 sc[2][2];
#pragma unroll
        for (int st = 0; st < 2; ++st)
#pragma unroll
            for (int tt = 0; tt < 2; ++tt) {
                f32x4 a = (f32x4){0.f, 0.f, 0.f, 0.f};
                if (!(st == 1 && tt == 0)) {
#pragma unroll
                    for (int kk = 0; kk < 4; ++kk) {
                        const bf16x8 A = *(const LAS bf16x8*)(kt + (16 * st + r16) * 272 + (32 * kk + 8 * quad) * 2);
                        const bf16x8 B = *(const LAS bf16x8*)(qt + (16 * tt + r16) * 272 + (32 * kk + 8 * quad) * 2);
                        a = MFMA16(A, B, a);
                    }
#pragma unroll
                    for (int j = 0; j < 4; ++j) { const int s = 16 * st + 4 * quad + j, t = 16 * tt + r16; if (s > t) a[j] = 0.f; }
                }
                sc[st][tt] = a;
            }
#pragma unroll
        for (int u = 0; u < 2; ++u) {
            const LAS unsigned char* bp = vT + (32 * c + 16 * u + r16) * 64 + (4 * quad) * 2;
            const v2u lo = *(const LAS v2u*)bp, hi = *(const LAS v2u*)(bp + 32);
            v4u bw; bw.x = lo.x; bw.y = lo.y; bw.z = hi.x; bw.w = hi.y;
            const bf16x8 Bv = __builtin_bit_cast(bf16x8, bw);
#pragma unroll
            for (int tt = 0; tt < 2; ++tt) o[u][tt] = MFMA16(pack8(sc[0][tt], sc[1][tt]), Bv, o[u][tt]);
        }
        {
            const bf16x8 Bv0 = *(const LAS bf16x8*)(vT + (32 * c + r16) * 64 + quad * 16), Bv1 = *(const LAS bf16x8*)(vT + (32 * c + 16 + r16) * 64 + quad * 16);
#pragma unroll
            for (int i = 0; i < 8; ++i) {
                const f32x4 pl = *(const LAS f32x4*)(plast + 16 * i + 4 * quad);
                const bf16x8 Ak = *(const LAS bf16x8*)(ktT + (16 * i + r16) * 64 + quad * 16);
                S[0][i] = MFMA16(Ak, Bv0, S[0][i]) * pl; S[1][i] = MFMA16(Ak, Bv1, S[1][i]) * pl;
            }
        }
#pragma unroll
        for (int tt = 0; tt < 2; ++tt)
#pragma unroll
            for (int j = 0; j < 4; ++j) {
                const int t = 16 * tt + 4 * quad + j;
                *(LAS float*)(ob + (t * 132 + 32 * c + r16) * 4) = o[0][tt][j];
                *(LAS float*)(ob + (t * 132 + 32 * c + 16 + r16) * 4) = o[1][tt][j];
                float v = o[0][tt][j] * o[0][tt][j] + o[1][tt][j] * o[1][tt][j];
                v += __shfl_xor(v, 1); v += __shfl_xor(v, 2); v += __shfl_xor(v, 4); v += __shfl_xor(v, 8);
                if (r16 == 0) *(LAS float*)(ob + RC_SSQ + (c * 32 + t) * 4) = v;
            }
    }
__device__ __forceinline__ void recur_item(int bh, const bf16* Q, const bf16* Fh, const bf16* V, const bf16* SZ, const float* normw, bf16* OG, LAS unsigned char* lds, int tid, size_t omask = ~(size_t)0) {
    const int b = bh >> 4, h = bh & 15;
    const int wave = __builtin_amdgcn_readfirstlane(tid >> 6), lane = tid & 63;
    const size_t rowb = (size_t)b * T, colbase = (size_t)h * 128;
    if (wave < 4) {
        PSet sa, sb, sc3; float nw[16];
        const int p = wave * 64 + lane, t = p & 31, oc = p >> 5;
#pragma unroll
        for (int e = 0; e < 8; ++e) { nw[e] = normw[8 * oc + e]; nw[8 + e] = normw[64 + 8 * oc + e]; }
        const v4u zz = (v4u){0u, 0u, 0u, 0u};
        rc_load(sa, Q, Fh, V, (rowb + t) * W + colbase + 8 * oc); sa.z0 = zz; sa.z1 = zz;
        rc_load(sb, Q, Fh, V, (rowb + 32 + t) * W + colbase + 8 * oc); sb.z0 = zz; sb.z1 = zz;
        sc3 = sa;
#pragma unroll
        for (int e = 0; e < 16; ++e) asm volatile("" :: "v"(nw[e]));
#pragma unroll 1
        for (int n = -1; n <= T / 32; n += 3) {
            rc_prod_step(n, sa, sc3, nw, Q, Fh, V, SZ, OG, colbase, rowb, lds, wave, lane, omask);
            RC_BAR();
            rc_prod_step(n + 1, sb, sa, nw, Q, Fh, V, SZ, OG, colbase, rowb, lds, wave, lane, omask);
            RC_BAR();
            rc_prod_step(n + 2, sc3, sb, nw, Q, Fh, V, SZ, OG, colbase, rowb, lds, wave, lane, omask);
            RC_BAR();
        }
    } else {
        f32x4 S[2][8];
#pragma unroll
        for (int u = 0; u < 2; ++u)
#pragma unroll
            for (int i = 0; i < 8; ++i) S[u][i] = (f32x4){0.f, 0.f, 0.f, 0.f};
        RC_BAR();
#pragma unroll 1
        for (int n = 0; n < T / 32; ++n) { rc_cons_step(n, S, lds, wave, lane); RC_BAR(); }
        RC_BAR();
    }
}

__device__ __forceinline__ int crow(int r, int hi) { return (r & 3) + 8 * (r >> 2) + 4 * hi; }
__device__ __forceinline__ void attn_item(int item, const bf16* Q, const bf16* K, const bf16* V, const bf16* SZ, const float* sinks, bf16* AG, LAS unsigned char* lds, int tid, size_t omask = ~(size_t)0) {
    const int blk = item & 15, kvh = (item >> 4) & 3, b = item >> 6;
    const int wave = tid >> 6, lane = tid & 63, r32 = lane & 31, hh = lane >> 5;
    LAS unsigned char* Ks = lds;
    LAS unsigned char* vT = lds + 36864;
    LAS unsigned char* ost = lds + 70656 + wave * 8704;
    const long row0 = (long)b * T + blk * 128 - 128;
#pragma unroll
    for (int p = 0; p < 4; ++p) {
        const int idx = p * 512 + tid, key = idx >> 3, part = idx & 7;
        v4u kv = (v4u){0u, 0u, 0u, 0u}, vv = kv;
        if (blk > 0 || key >= 128) { kv = *(const v4u*)(K + (size_t)(row0 + key) * KVW + kvh * 64 + part * 8); vv = *(const v4u*)(V + (size_t)(row0 + key) * KVW + kvh * 64 + part * 8); }
        *(LAS v4u*)(Ks + key * 144 + part * 16) = kv;
#pragma unroll
        for (int e = 0; e < 8; ++e) { const unsigned wv = vv[e >> 1]; *(LAS unsigned short*)(vT + (part * 8 + e) * 528 + key * 2) = (unsigned short)((e & 1) ? (wv >> 16) : (wv & 0xffffu)); }
    }
    __syncthreads();
    const int hq = kvh * 8 + wave;
    const float slope2 = exp2f(-0.25f * (float)(hq + 1)) * LOG2E, sink2 = sinks[hq] * LOG2E;
    const int rm = r32 - 4 * hh;
    f32x16 cb;
#pragma unroll
    for (int i = 0; i < 16; ++i) cb[i] = slope2 * (float)((i & 3) + 8 * (i >> 2) + 4 * hh);
#pragma unroll 1
    for (int qt = 0; qt < 4; ++qt) {
        const size_t qrow = (size_t)b * T + blk * 128 + 32 * qt + r32;
        bf16x8 qf[4];
#pragma unroll
        for (int s = 0; s < 4; ++s) qf[s] = *(const bf16x8*)(Q + qrow * W + hq * 64 + 16 * s + 8 * hh);
        const float sinkq = sink2 + slope2 * (float)(128 + 32 * qt + r32);
        f32x16 sT[5];
#pragma unroll
        for (int j = 0; j < 5; ++j) {
            f32x16 a;
            const bool ok = (blk > 0) || (qt + j >= 4);
            if (ok) {
                const float sj = slope2 * (float)(32 * (qt + j));
#pragma unroll
                for (int i = 0; i < 16; ++i) a[i] = cb[i] + sj;
#pragma unroll
                for (int s = 0; s < 4; ++s) { const bf16x8 A = *(const LAS bf16x8*)(Ks + (32 * (qt + j) + r32) * 144 + (16 * s + 8 * hh) * 2); a = MFMA32(A, qf[s], a); }
                if (j == 0) {
#pragma unroll
                    for (int i = 0; i < 16; ++i) if (((i & 3) + 8 * (i >> 2)) <= rm) a[i] = -INFINITY;
                }
                if (j == 4) {
#pragma unroll
                    for (int i = 0; i < 16; ++i) if (((i & 3) + 8 * (i >> 2)) > rm) a[i] = -INFINITY;
                }
            } else {
#pragma unroll
                for (int i = 0; i < 16; ++i) a[i] = -INFINITY;
            }
            sT[j] = a;
            __builtin_amdgcn_sched_barrier(0);
        }
        float mx = sinkq;
#pragma unroll
        for (int j = 0; j < 5; ++j)
#pragma unroll
            for (int i = 0; i < 16; ++i) mx = fmaxf(mx, sT[j][i]);
        mx = fmaxf(mx, __shfl_xor(mx, 32));
        float l = 0.f;
#pragma unroll
        for (int j = 0; j < 5; ++j)
#pragma unroll
            for (int i = 0; i < 16; ++i) { const float pe = exp2f(sT[j][i] - mx); sT[j][i] = pe; l += pe; }
        l += __shfl_xor(l, 32); l += exp2f(sinkq - mx);
        const float inv = 1.0f / l;
        f32x16 oT[2];
#pragma unroll
        for (int i = 0; i < 16; ++i) { oT[0][i] = 0.f; oT[1][i] = 0.f; }
#pragma unroll
        for (int j = 0; j < 5; ++j)
#pragma unroll
            for (int s = 0; s < 2; ++s) {
                v4u pw; pw.x = pk2(sT[j][8 * s + 0], sT[j][8 * s + 1]); pw.y = pk2(sT[j][8 * s + 2], sT[j][8 * s + 3]); pw.z = pk2(sT[j][8 * s + 4], sT[j][8 * s + 5]); pw.w = pk2(sT[j][8 * s + 6], sT[j][8 * s + 7]);
                const bf16x8 pb = __builtin_bit_cast(bf16x8, pw);
#pragma unroll
                for (int dt = 0; dt < 2; ++dt) {
                    const LAS unsigned char* ap = vT + (32 * dt + r32) * 528 + (32 * (qt + j) + 16 * s + 4 * hh) * 2;
                    const v2u lo = *(const LAS v2u*)ap, hi = *(const LAS v2u*)(ap + 16);
                    v4u aw; aw.x = lo.x; aw.y = lo.y; aw.z = hi.x; aw.w = hi.y;
                    oT[dt] = MFMA32(__builtin_bit_cast(bf16x8, aw), pb, oT[dt]);
                }
                __builtin_amdgcn_sched_barrier(0);
            }
#pragma unroll
        for (int dt = 0; dt < 2; ++dt)
#pragma unroll
            for (int ig = 0; ig < 4; ++ig) { f32x4 v; v[0] = oT[dt][4 * ig] * inv; v[1] = oT[dt][4 * ig + 1] * inv; v[2] = oT[dt][4 * ig + 2] * inv; v[3] = oT[dt][4 * ig + 3] * inv;
                *(LAS f32x4*)(ost + r32 * 272 + (32 * dt + 8 * ig + 4 * hh) * 4) = v; }
        LDS_WAIT();
#pragma unroll
        for (int it = 0; it < 4; ++it) {
            const int idx = it * 64 + lane, q = idx >> 3, part = idx & 7;
            const f32x4 a0 = *(const LAS f32x4*)(ost + q * 272 + part * 32), a1 = *(const LAS f32x4*)(ost + q * 272 + part * 32 + 16);
            const size_t gi = ((size_t)b * T + blk * 128 + 32 * qt + q) * W + hq * 64 + part * 8;
            const v4u z = *(const v4u*)(SZ + gi);
            v4u w; w.x = pk2(a0[0] * bflo(z.x), a0[1] * bfhi(z.x)); w.y = pk2(a0[2] * bflo(z.y), a0[3] * bfhi(z.y));
            w.z = pk2(a1[0] * bflo(z.z), a1[1] * bfhi(z.z)); w.w = pk2(a1[2] * bflo(z.w), a1[3] * bfhi(z.w));
            *(v4u*)(AG + (gi & omask)) = w;
        }
        LDS_WAIT();
    }
    __syncthreads();
}

#define XB_TMO      128
#define XB_XCNT(j)  (256  + 64 * (j))
#define XB_XSUB(j)  (1280 + 64 * (j))
#define XB_XGEN(j)  (2304 + 64 * (j))
#define XB_TOP      3328
#define XB_TOPGEN   3392
#define XCD_BAR_WORDS 3456
#define XB_SPIN_CAP (1u << 18)

__device__ __forceinline__ unsigned xb_ld(unsigned* p)              { return __hip_atomic_load(p, __ATOMIC_RELAXED, __HIP_MEMORY_SCOPE_AGENT); }
__device__ __forceinline__ unsigned xb_add(unsigned* p, unsigned v) { return __hip_atomic_fetch_add(p, v, __ATOMIC_RELAXED, __HIP_MEMORY_SCOPE_AGENT); }
__device__ __forceinline__ unsigned xb_xcc_id() { return (unsigned)__builtin_amdgcn_s_getreg((3 << 11) | 20) & 0xFu; }
#define XB_SPIN(cond, bar) do { unsigned _sp = 0; while (cond) { __builtin_amdgcn_s_sleep(1); \
    if ((++_sp & 255u) == 0u) { if (xb_ld(&(bar)[XB_TMO])) break; if (_sp > XB_SPIN_CAP) { atomicAdd(&(bar)[XB_TMO], 1u); break; } } } } while (0)

struct XcdBarrier {
    unsigned* bar; unsigned x;
    volatile LAS unsigned* st;
};

__device__ __forceinline__ XcdBarrier xcd_barrier_post(unsigned* bar, volatile LAS unsigned* st) {
    XcdBarrier b; b.bar = bar; b.x = xb_xcc_id(); b.st = st;
    if (threadIdx.x == 0) (void)xb_add(&bar[XB_XCNT(b.x)], 1u);
    return b;
}
__device__ __forceinline__ void xcd_barrier_complete(unsigned* bar, unsigned x, unsigned& nloc, unsigned& nx) {
    const unsigned G = gridDim.x * gridDim.y * gridDim.z;
    unsigned sum, cnt, mine, sp = 0u;
    for (;;) {
        sum = 0u; cnt = 0u; mine = 0u;
#pragma unroll
        for (unsigned j = 0; j < 16; ++j) { const unsigned c = xb_ld(&bar[XB_XCNT(j)]); sum += c; cnt += (c > 0u) ? 1u : 0u; mine = (j == x) ? c : mine; }
        if (sum == G) break;
        __builtin_amdgcn_s_sleep(1);
        if ((++sp & 255u) == 0u) { if (xb_ld(&bar[XB_TMO])) break; if (sp > XB_SPIN_CAP) { atomicAdd(&bar[XB_TMO], 1u); break; } }
    }
    nloc = mine > 0u ? mine : 1u; nx = cnt > 0u ? cnt : 1u;
}

__device__ __forceinline__ void xcd_barrier(const XcdBarrier& b) {
    asm volatile("s_waitcnt vmcnt(0)" ::: "memory");
    __syncthreads();
    if (threadIdx.x == 0) {
        unsigned* bar = b.bar;
        __builtin_amdgcn_s_waitcnt(0);
        unsigned nloc = b.st[0], nx = b.st[1];
        if (nloc == 0u) { xcd_barrier_complete(bar, b.x, nloc, nx); b.st[0] = nloc; b.st[1] = nx; }
        const unsigned old = xb_add(&bar[XB_XSUB(b.x)], 1u);
        const unsigned gen = old / nloc;
        if (old + 1u == (gen + 1u) * nloc) {
            __builtin_amdgcn_fence(__ATOMIC_RELEASE, "agent");
            asm volatile("s_waitcnt vmcnt(0)" ::: "memory");
            const unsigned og = xb_add(&bar[XB_TOP], 1u);
            const unsigned tg = og / nx;
            if (og + 1u == (tg + 1u) * nx) xb_add(&bar[XB_TOPGEN], 1u);
            else XB_SPIN(xb_ld(&bar[XB_TOPGEN]) == tg, bar);
            __builtin_amdgcn_fence(__ATOMIC_ACQUIRE, "agent");
            xb_add(&bar[XB_XGEN(b.x)], 1u);
            asm volatile("s_waitcnt vmcnt(0)" ::: "memory");
        } else {
            XB_SPIN(xb_ld(&bar[XB_XGEN(b.x)]) == gen, bar);
            __builtin_amdgcn_fence(__ATOMIC_ACQUIRE, "agent");
            asm volatile("s_waitcnt vmcnt(0)" ::: "memory");
        }
    }
    __syncthreads();
}

struct Args { const float* in[13]; float* out; unsigned char* ws; };
__global__ void __launch_bounds__(NTHR, 2) fwd_megakernel(Args a) {
    extern __shared__ __attribute__((aligned(16))) unsigned char lds_raw[];
    LAS unsigned char* lds = (LAS unsigned char*)lds_raw;
    cg::grid_group grid = cg::this_grid();
    const int tid = threadIdx.x, lane = tid & 63, wave = __builtin_amdgcn_readfirstlane(tid >> 6);
    const int G = gridDim.x, bx = blockIdx.x;
    const int gw = bx * NWAVES + wave, NGW = G * NWAVES;
    const float* x = a.in[0]; const float* c = a.in[1]; const float* ada_w = a.in[2]; const float* ada_b = a.in[3];
    const float* ln_g = a.in[4]; const float* ln_b = a.in[5]; const float* hg_w_in = a.in[6]; const float* hg_w_out = a.in[7];
    const float* lbl = a.in[8]; const float* hg_nw = a.in[9]; const float* sw_w_in = a.in[10]; const float* sw_w_out = a.in[11]; const float* sinks = a.in[12];
    unsigned char* ws = a.ws;
    float* mod = (float*)(ws + WS_MOD);
    bf16* WA = (bf16*)(ws + WS_WA); bf16* WO0 = (bf16*)(ws + WS_WO0); bf16* WO1 = (bf16*)(ws + WS_WO1);
    bf16* H = (bf16*)(ws + WS_H); bf16* Qb = (bf16*)(ws + WS_Q); bf16* Fb = (bf16*)(ws + WS_F); bf16* Vb = (bf16*)(ws + WS_V);
    float* X1 = (float*)(ws + WS_F); float* U0 = (float*)(ws + WS_V);
    bf16* K1 = (bf16*)(ws + WS_V); bf16* V1 = (bf16*)(ws + WS_V + 8 * MiB);
    bf16* SZ = (bf16*)a.out;
    LAS float* scr = (LAS float*)(lds + wave * 16384);
    volatile LAS unsigned* bst = (volatile LAS unsigned*)(lds + LDS_BYTES - 64);
    if (tid < 2) bst[tid] = 0u;
    __syncthreads();
    XcdBarrier xbar = xcd_barrier_post((unsigned*)(ws + WS_BAR), bst);
#define GSYNC() xcd_barrier(xbar)

    for (int it = bx; it < 96; it += G) mod_item(c, ada_w, ada_b, mod, it, (LAS float*)lds, tid);
    {
        constexpr int I_A = (D / 64) * (N1 / 32), I_O = (W / 64) * (D / 32);
        for (int it = gw; it < I_A + 2 * I_O; it += NGW) {
            int r = it;
            if (r < I_A) { transpose_item(hg_w_in, D, N1, WA, scr, r, lane); continue; } r -= I_A;
            if (r < I_O) { transpose_item(hg_w_out, W, D, WO0, scr, r, lane); continue; } r -= I_O;
            transpose_item(sw_w_out, W, D, WO1, scr, r, lane);
        }
    }
    grid.sync();
    hmod_rows(x, mod, H, gw, NGW, lane);
    GSYNC();
    { pg8::Gemm g{H, WA, M, N1, D}; pg8::StaticOrder S; S.init(M, N1, G, bx); EpiL0 E{Qb, Fb, Vb, SZ, lbl};
      pg8::gemm_phase<EpiL0, pg8::StaticOrder, true, true>(lds, g, S, E); }
    GSYNC();
    {
        constexpr int I_B = (D / 64) * (N3 / 32);
        if (G >= 256) {
            if (bx < 128) { recur_item(bx, Qb, Fb, Vb, SZ, hg_nw, Qb, lds, tid); }
            else { for (int it = (bx - 128) * NWAVES + wave; it < I_B; it += (G - 128) * NWAVES) transpose_item(sw_w_in, D, N3, WA, scr, it, lane); }
        } else {
            for (int it = gw; it < I_B; it += NGW) transpose_item(sw_w_in, D, N3, WA, scr, it, lane);
            __syncthreads();
            for (int bh = bx; bh < 128; bh += G) recur_item(bh, Qb, Fb, Vb, SZ, hg_nw, Qb, lds, tid);
        }
    }
    GSYNC();
    { pg8::Gemm g{Qb, WO0, M, D, W}; pg8::StaticOrder S; S.init(M, D, G, bx); EpiRes E{x, mod + 2048, U0};
      pg8::gemm_phase<EpiRes, pg8::StaticOrder, false, true>(lds, g, S, E); }
    GSYNC();
    ln_rows(U0, ln_g, ln_b, X1, mod + 8 * 3072, H, gw, NGW, lane);
    GSYNC();
    { pg8::Gemm g{H, WA, M, N3, D}; pg8::StaticOrder S; S.init(M, N3, G, bx); EpiL1 E{Qb, K1, V1, SZ};
      pg8::gemm_phase<EpiL1, pg8::StaticOrder, true, true>(lds, g, S, E); }
    GSYNC();
    for (int it = bx; it < BATCH * 4 * 16; it += G) attn_item(it, Qb, K1, V1, SZ, sinks, Qb, lds, tid);
    GSYNC();
    { pg8::Gemm g{Qb, WO1, M, D, W}; pg8::StaticOrder S; S.init(M, D, G, bx); EpiRes E{X1, mod + 8 * 3072 + 2048, a.out};
      pg8::gemm_phase<EpiRes, pg8::StaticOrder, false, true>(lds, g, S, E); }
    GSYNC();
    ln_rows(a.out, ln_g + D, ln_b + D, a.out, nullptr, nullptr, gw, NGW, lane);
}

extern "C" void kernel_launch(void* const* d_in, const int* in_sizes, int n_in, void* d_out, int out_size, void* d_ws, size_t ws_size, hipStream_t stream) {
    static int grid = 0;
    if (grid == 0) {
        int dev = 0, cus = 0, per_cu = 0;
        if (hipGetDevice(&dev) != hipSuccess || hipDeviceGetAttribute(&cus, hipDeviceAttributeMultiprocessorCount, dev) != hipSuccess) { fprintf(stderr, "kernel_launch: device query failed\n"); grid = -1; return; }
        if (hipFuncSetAttribute((const void*)fwd_megakernel, hipFuncAttributeMaxDynamicSharedMemorySize, LDS_BYTES) != hipSuccess) { fprintf(stderr, "kernel_launch: hipFuncSetAttribute failed\n"); grid = -1; return; }
        if (hipOccupancyMaxActiveBlocksPerMultiprocessor(&per_cu, (const void*)fwd_megakernel, NTHR, LDS_BYTES) != hipSuccess || per_cu < 1) { fprintf(stderr, "kernel_launch: occupancy query gave %d\n", per_cu); per_cu = 1; }
        (void)hipGetLastError();
        grid = cus * per_cu;
        fprintf(stderr, "kernel_launch: grid %d (cus %d x %d), ws %zu\n", grid, cus, per_cu, ws_size);
    }
    if (grid < 0) return;
    if (hipMemsetAsync((char*)d_ws + WS_BAR, 0, XCD_BAR_WORDS * 4, stream) != hipSuccess) { fprintf(stderr, "kernel_launch: memset failed\n"); return; }
    Args a{};
    for (int i = 0; i < 13; ++i) a.in[i] = (const float*)d_in[i];
    a.out = (float*)d_out; a.ws = (unsigned char*)d_ws;
    void* args[] = {&a};
    hipError_t e = hipLaunchCooperativeKernel((const void*)fwd_megakernel, dim3(grid), dim3(NTHR), args, LDS_BYTES, stream);
    if (e != hipSuccess) fprintf(stderr, "kernel_launch: cooperative launch failed: %s (grid %d)\n", hipGetErrorString(e), grid);
}
```
